# Optimizing an MI355X kernel written in HIP

```python
import math
import jax, jax.numpy as jnp
from jax import lax
import numpy as np

D_MODEL = 2048
BATCH = 16
SEQ = 256
DEPTH = 2
DEC_BATCH = 2
DEC_SEQ = 4096
PAST_LEN = 512

GRID_W = 64
GDN_HEADS = 4
GDN_DK = 128
GDN_DV = 128
GDN_W = GDN_HEADS * GDN_DV
CONV_K = 4
CHUNK = 64
DIFF_HEADS = 8
DIFF_DQK = 64
DIFF_DV = 2 * DIFF_DQK
DIFF_QK_W = DIFF_HEADS * 2 * DIFF_DQK
DIFF_W = DIFF_HEADS * DIFF_DV
Q_BLOCK = 128
ROPE_BASE = 10000.0
POOL_WINDOWS = (2, 4, 8, 16)
POOL_GROUPS = len(POOL_WINDOWS)
POOL_GW = 128
POOL_W = POOL_GROUPS * POOL_GW
MIX_W = GDN_W + DIFF_W + POOL_W
D_FF = 5632
N_MOD = 9
EPS = 1e-6
IN_SPLIT_SIZES = (3 * GDN_W, GDN_W, 2 * GDN_HEADS, 2 * GDN_HEADS, DIFF_QK_W, DIFF_QK_W, DIFF_W, POOL_W)
IN_COLS = sum(IN_SPLIT_SIZES)
IN_SPLITS = tuple(int(s) for s in np.cumsum(IN_SPLIT_SIZES)[:-1])

kernel_name = 'hybrid_gdn_diffattn_pool_macaron_prefix_step'


def lambda_init(l):
    return 0.8 - 0.6 * math.exp(-0.3 * l)


def rmsnorm(x, g):
    xf = x.astype(jnp.float32)
    y = xf * lax.rsqrt(jnp.mean(xf * xf, axis=-1, keepdims=True) + EPS)
    return (y * g.astype(jnp.float32)).astype(x.dtype)


def l2norm(x):
    xf = x.astype(jnp.float32)
    return (xf * lax.rsqrt(jnp.sum(xf * xf, axis=-1, keepdims=True) + EPS)).astype(x.dtype)


def modulate(x, shift, scale):
    return x * (1.0 + scale) + shift


def swiglu(h, w_in, w_out):
    gate, up = jnp.split(h @ w_in, 2, axis=-1)
    return (jax.nn.silu(gate) * up) @ w_out


def short_conv(x, w):
    L = x.shape[1]
    left = CONV_K // 2
    xp = jnp.pad(x, ((0, 0), (left, CONV_K - 1 - left), (0, 0)))
    return sum(xp[:, j:j + L] * w[j] for j in range(CONV_K))


def axial_rope(x):
    L = x.shape[1]
    rows = L // GRID_W
    row = jnp.broadcast_to(jnp.arange(rows)[:, None], (rows, GRID_W)).reshape(L).astype(jnp.float32)
    col = jnp.broadcast_to(jnp.arange(GRID_W)[None, :], (rows, GRID_W)).reshape(L).astype(jnp.float32)
    half = DIFF_DQK // 2
    inv_freq = ROPE_BASE ** (-jnp.arange(0, half, 2, dtype=jnp.float32) / half)

    def rot(xa, pos):
        ang = pos[:, None] * inv_freq[None, :]
        cos = jnp.cos(ang)[None, :, None, None, :]
        sin = jnp.sin(ang)[None, :, None, None, :]
        x1, x2 = jnp.split(xa.astype(jnp.float32), 2, axis=-1)
        return jnp.concatenate([x1 * cos - x2 * sin, x1 * sin + x2 * cos], axis=-1)

    out = jnp.concatenate([rot(x[..., :half], row), rot(x[..., half:], col)], axis=-1)
    return out.astype(x.dtype)


def gdn_chunked(q, k, v, g, beta, s0):
    B, L, H, _ = q.shape
    n = L // CHUNK
    f32 = jnp.float32

    def to_chunks(t):
        t = t.astype(f32).reshape((B, n, CHUNK, H) + t.shape[3:])
        return jnp.moveaxis(t, 3, 2)

    qc, kc, vc = to_chunks(q), to_chunks(k), to_chunks(v)
    gc = jnp.cumsum(to_chunks(g), axis=-1)
    bc = to_chunks(beta)
    kb = kc * bc[..., None]
    vb = vc * bc[..., None]
    tri = jnp.tril(jnp.ones((CHUNK, CHUNK), bool))
    strict = jnp.tril(jnp.ones((CHUNK, CHUNK), bool), k=-1)
    decay = jnp.exp(jnp.where(tri, gc[..., :, None] - gc[..., None, :], -jnp.inf))
    lmat = jnp.where(strict, jnp.einsum('bnhid,bnhjd->bnhij', kb, kc) * decay, 0.0)
    eye = jnp.eye(CHUNK, dtype=f32)
    tmat = lax.linalg.triangular_solve(eye + lmat, jnp.broadcast_to(eye, lmat.shape),
                                       left_side=True, lower=True, unit_diagonal=True)
    u = jnp.einsum('bnhij,bnhjv->bnhiv', tmat, vb)
    w = jnp.einsum('bnhij,bnhjk->bnhik', tmat, kb * jnp.exp(gc)[..., None])
    a_intra = jnp.einsum('bnhid,bnhjd->bnhij', qc, kc) * decay
    qg = qc * jnp.exp(gc)[..., None]
    kd = kc * jnp.exp(gc[..., -1:] - gc)[..., None]
    glast = jnp.exp(gc[..., -1])

    def step(S, xs):
        u_i, w_i, qg_i, a_i, kd_i, gl_i = xs
        v_new = u_i - jnp.einsum('bhck,bhkv->bhcv', w_i, S)
        o = jnp.einsum('bhck,bhkv->bhcv', qg_i, S) + jnp.einsum('bhij,bhjv->bhiv', a_i, v_new)
        S = S * gl_i[..., None, None] + jnp.einsum('bhck,bhcv->bhkv', kd_i, v_new)
        return S, o

    xs = tuple(jnp.moveaxis(t, 1, 0) for t in (u, w, qg, a_intra, kd, glast))
    s_fin, o = lax.scan(step, s0.astype(f32), xs)
    o = o.transpose(1, 0, 3, 2, 4).reshape(B, L, H, v.shape[-1])
    return o.astype(v.dtype), s_fin


def diff_attention(q, k, v, lam):
    B, Lq, H = q.shape[:3]
    nb = Lq // Q_BLOCK
    qb = jnp.moveaxis(q.reshape(B, nb, Q_BLOCK, H, 2, DIFF_DQK), 1, 0)
    scale = DIFF_DQK ** -0.5

    def block(qi):
        s = jnp.einsum('bqhmd,bkhmd->bmhqk', qi, k, preferred_element_type=jnp.float32) * scale
        p = jax.nn.softmax(s, axis=-1)
        pd = p[:, 0] - lam * p[:, 1]
        return jnp.einsum('bhqk,bkhv->bqhv', pd.astype(v.dtype), v)

    o = lax.map(block, qb)
    return jnp.moveaxis(o, 0, 1).reshape(B, Lq, H, v.shape[-1])


def centred_mean(x, w):
    B, L, C = x.shape
    a = w // 2
    b = w - a - 1
    cs = jnp.concatenate([jnp.zeros((B, 1, C), jnp.float32), jnp.cumsum(x.astype(jnp.float32), axis=1)], axis=1)
    t = jnp.arange(L)
    lo = jnp.clip(t - a, 0, L)
    hi = jnp.clip(t + b + 1, 0, L)
    cnt = (hi - lo).astype(jnp.float32)
    return ((cs[:, hi] - cs[:, lo]) / cnt[None, :, None]).astype(x.dtype)


def token_mixing(h, lp, l, ctx):
    B, L, _ = h.shape
    proj = h @ lp['w_in']
    qkv, z, a, b, dq, dk, dv, pin = jnp.split(proj, IN_SPLITS, axis=-1)

    qkv = jax.nn.silu(short_conv(qkv, lp['gdn_conv']))
    gq, gk, gv = jnp.split(qkv, 3, axis=-1)
    gq = l2norm(gq.reshape(B, L, GDN_HEADS, GDN_DK)) * (GDN_DK ** -0.5)
    gk = l2norm(gk.reshape(B, L, GDN_HEADS, GDN_DK))
    gv = gv.reshape(B, L, GDN_HEADS, GDN_DV)
    a = a.reshape(B, L, 2, GDN_HEADS).astype(jnp.float32)
    g = -jnp.exp(lp['gdn_a_log'].astype(jnp.float32)) * jax.nn.softplus(a + lp['gdn_dt_bias'].astype(jnp.float32))
    beta = jax.nn.sigmoid(b.reshape(B, L, 2, GDN_HEADS).astype(jnp.float32))
    if ctx is None:
        s0 = jnp.zeros((B, 2, GDN_HEADS, GDN_DK, GDN_DV), jnp.float32)
    else:
        s0 = ctx[2]
    flip = lambda t: jnp.flip(t, axis=1)
    o_f, s_f = gdn_chunked(gq, gk, gv, g[:, :, 0], beta[:, :, 0], s0[:, 0])
    o_b, s_b = gdn_chunked(flip(gq), flip(gk), flip(gv), flip(g[:, :, 1]), flip(beta[:, :, 1]), s0[:, 1])
    o_gdn = rmsnorm(o_f + flip(o_b), lp['gdn_norm']) * jax.nn.silu(z.reshape(B, L, GDN_HEADS, GDN_DV))

    dq = dq.reshape(B, L, DIFF_HEADS, 2, DIFF_DQK)
    dk = dk.reshape(B, L, DIFF_HEADS, 2, DIFF_DQK)
    dv = dv.reshape(B, L, DIFF_HEADS, DIFF_DV)
    if ctx is None:
        keys, vals, queries = dk, dv, dq
    else:
        ck = ctx[0].reshape(B, -1, DIFF_HEADS, 2, DIFF_DQK)
        keys = jnp.concatenate([ck, axial_rope(dk)], axis=1)
        vals = jnp.concatenate([ctx[1], dv], axis=1)
        queries = axial_rope(dq)
    lam_vec = lp['diff_lam'].astype(jnp.float32)
    lam_init = lambda_init(l)
    lam = jnp.exp(jnp.sum(lam_vec[0] * lam_vec[1])) - jnp.exp(jnp.sum(lam_vec[2] * lam_vec[3])) + lam_init
    o_diff = rmsnorm(diff_attention(queries, keys, vals, lam), lp['diff_norm']) * (1.0 - lam_init)

    pg = pin.reshape(B, L, POOL_GROUPS, POOL_GW)
    pooled = jnp.stack([centred_mean(pg[:, :, i], w) - pg[:, :, i] for i, w in enumerate(POOL_WINDOWS)], axis=2)
    o_pool = jnp.einsum('blgc,gcd->blgd', pooled, lp['pool_w']).reshape(B, L, POOL_W) * lp['pool_scale']

    cat = jnp.concatenate([o_gdn.reshape(B, L, GDN_W), o_diff.reshape(B, L, DIFF_W), o_pool], axis=-1)
    out = cat @ lp['w_out']
    if ctx is None:
        ctx_out = (dk.reshape(B, L, DIFF_HEADS, 2 * DIFF_DQK), dv, jnp.stack([s_f, s_b], axis=1).astype(h.dtype))
    else:
        ctx_out = None
    return out, ctx_out


def trunk_layer(x, cond, lp, l, ctx):
    ada = jax.nn.silu(cond) @ lp['w_ada'] + lp['b_ada']
    sh1, sc1, g1, shm, scm, gm, sh2, sc2, g2 = [t[:, None, :] for t in jnp.split(ada, N_MOD, axis=-1)]
    h = modulate(rmsnorm(x, lp['norm_ffn1']), sh1, sc1)
    x = x + 0.5 * g1 * swiglu(h, lp['ffn1_in'], lp['ffn1_out'])
    h = modulate(rmsnorm(x, lp['norm_mix']), shm, scm)
    mixed, ctx_out = token_mixing(h, lp, l, ctx)
    x = x + gm * mixed
    h = modulate(rmsnorm(x, lp['norm_ffn2']), sh2, sc2)
    x = x + 0.5 * g2 * swiglu(h, lp['ffn2_in'], lp['ffn2_out'])
    return x, ctx_out


def setup_inputs(seed: int = 0) -> dict:
    key = jax.random.key(seed)
    ks = jax.random.split(key, 32)
    f32 = jnp.float32
    nrm = lambda k, shape, s: jax.random.normal(k, shape, f32) * s
    gain = lambda k, shape: 1.0 + 0.02 * jax.random.normal(k, shape, f32)
    dt = jnp.exp(jax.random.uniform(ks[15], (DEPTH, 2, GDN_HEADS), f32, math.log(1e-3), math.log(1e-1)))
    return {
        'x_prompt': nrm(ks[0], (BATCH, SEQ, D_MODEL), 1.0),
        'x_sample': nrm(ks[1], (DEC_BATCH, DEC_SEQ, D_MODEL), 1.0),
        'c': nrm(ks[2], (DEC_BATCH, D_MODEL), 1.0),
        'cache_k': nrm(ks[3], (DEC_BATCH, DEPTH, PAST_LEN, DIFF_HEADS, 2 * DIFF_DQK), 1.0),
        'cache_v': nrm(ks[4], (DEC_BATCH, DEPTH, PAST_LEN, DIFF_HEADS, DIFF_DV), 1.0),
        'state_gdn': nrm(ks[5], (DEC_BATCH, DEPTH, 2, GDN_HEADS, GDN_DK, GDN_DV), 0.3),
        'c_ctx': nrm(ks[6], (D_MODEL,), 1.0),
        'w_ada': nrm(ks[7], (DEPTH, D_MODEL, N_MOD * D_MODEL), 0.3 * D_MODEL ** -0.5),
        'b_ada': nrm(ks[8], (DEPTH, N_MOD * D_MODEL), 0.02),
        'norm_ffn1': gain(ks[9], (DEPTH, D_MODEL)),
        'ffn1_in': nrm(ks[10], (DEPTH, D_MODEL, 2 * D_FF), D_MODEL ** -0.5),
        'ffn1_out': nrm(ks[11], (DEPTH, D_FF, D_MODEL), D_FF ** -0.5),
        'norm_mix': gain(ks[12], (DEPTH, D_MODEL)),
        'w_in': nrm(ks[13], (DEPTH, D_MODEL, IN_COLS), D_MODEL ** -0.5),
        'gdn_conv': nrm(ks[14], (DEPTH, CONV_K, 3 * GDN_W), CONV_K ** -0.5),
        'gdn_a_log': jnp.log(jax.random.uniform(ks[16], (DEPTH, 2, GDN_HEADS), f32, 1.0, 16.0)),
        'gdn_dt_bias': dt + jnp.log(-jnp.expm1(-dt)),
        'gdn_norm': gain(ks[17], (DEPTH, GDN_DV)),
        'diff_lam': nrm(ks[18], (DEPTH, 4, DIFF_DQK), 0.1),
        'diff_norm': gain(ks[19], (DEPTH, DIFF_DV)),
        'pool_w': nrm(ks[20], (DEPTH, POOL_GROUPS, POOL_GW, POOL_GW), POOL_GW ** -0.5),
        'pool_scale': gain(ks[21], (DEPTH, POOL_W)),
        'w_out': nrm(ks[22], (DEPTH, MIX_W, D_MODEL), MIX_W ** -0.5),
        'norm_ffn2': gain(ks[23], (DEPTH, D_MODEL)),
        'ffn2_in': nrm(ks[24], (DEPTH, D_MODEL, 2 * D_FF), D_MODEL ** -0.5),
        'ffn2_out': nrm(ks[25], (DEPTH, D_FF, D_MODEL), D_FF ** -0.5),
        'final_norm': gain(ks[26], (D_MODEL,)),
    }


def reference(x_prompt, x_sample, c, cache_k, cache_v, state_gdn, c_ctx, w_ada, b_ada, norm_ffn1, ffn1_in,
              ffn1_out, norm_mix, w_in, gdn_conv, gdn_a_log, gdn_dt_bias, gdn_norm, diff_lam, diff_norm,
              pool_w, pool_scale, w_out, norm_ffn2, ffn2_in, ffn2_out, final_norm):
    lps = [dict(w_ada=w_ada[l], b_ada=b_ada[l], norm_ffn1=norm_ffn1[l], ffn1_in=ffn1_in[l], ffn1_out=ffn1_out[l],
                norm_mix=norm_mix[l], w_in=w_in[l], gdn_conv=gdn_conv[l], gdn_a_log=gdn_a_log[l],
                gdn_dt_bias=gdn_dt_bias[l], gdn_norm=gdn_norm[l], diff_lam=diff_lam[l], diff_norm=diff_norm[l],
                pool_w=pool_w[l], pool_scale=pool_scale[l], w_out=w_out[l], norm_ffn2=norm_ffn2[l],
                ffn2_in=ffn2_in[l], ffn2_out=ffn2_out[l]) for l in range(DEPTH)]

    yp = x_prompt
    ks_, vs_, ss_ = [], [], []
    for l in range(DEPTH):
        yp, (k_l, v_l, s_l) = trunk_layer(yp, c_ctx[None, :], lps[l], l, None)
        ks_.append(k_l)
        vs_.append(v_l)
        ss_.append(s_l)
    y_prompt = rmsnorm(yp, final_norm)
    new_cache_k = jnp.stack(ks_, axis=1)
    new_cache_v = jnp.stack(vs_, axis=1)
    new_state_gdn = jnp.stack(ss_, axis=1)

    ys = x_sample
    for l in range(DEPTH):
        ys, _ = trunk_layer(ys, c, lps[l], l, (cache_k[:, l], cache_v[:, l], state_gdn[:, l]))
    y_sample = rmsnorm(ys, final_norm)
    return (y_prompt, y_sample, new_cache_k, new_cache_v, new_state_gdn)
```

```cpp
#include <hip/hip_runtime.h>
#include <cstdio>
#include <cstdint>
namespace pg8 {
#define PG8_LAS __attribute__((address_space(3)))
typedef unsigned short bf16_t;
typedef short bf16x8 __attribute__((ext_vector_type(8)));
typedef float f32x4 __attribute__((ext_vector_type(4)));
typedef unsigned u32x4 __attribute__((ext_vector_type(4)));
constexpr int BM = 256, BK = 64, HALF = 128, HTB = HALF * BK * 2  , STAGE_BYTES = 8 * HTB, NXCD = 8, WGM = 8;

__host__ __device__ __forceinline__ int lds_byte(int r, int c) { const int st = (r >> 4) * 2 + (c >> 5), rr = r & 15, cc = c & 31, ob = rr * 64 + cc * 2; return st * 1024 + (ob ^ (((ob >> 9) & 1) << 5)); }
__host__ __device__ __forceinline__ void stage_rc(int b, int& R, int& C) { const int st = b / 1024, sb = b % 1024, swz = sb ^ (((sb >> 9) & 1) << 5); R = (st >> 1) * 16 + swz / 64; C = (st & 1) * 32 + (swz % 64) / 2; }
__host__ __device__ __forceinline__ int perm32(int rho) { const int n = rho >> 4, i = rho & 15; return 8 * (i >> 2) + 4 * n + (i & 3); }

struct Unit { int pm, pn, half; };
struct Gemm { const bf16_t* A; const bf16_t* Bt; int M, N, K, pad; };

struct StaticOrder {
    int nM, nN, nwg, G, c, nfull, halves;
    __host__ __device__ __forceinline__ void init(int M, int N, int G_, int c_, int bm = BM) { nM = M / bm; nN = N / BM; nwg = nM * nN; G = G_; c = c_; nfull = (nwg / G) * G; const int rem = nwg - nfull; halves = (bm == BM && rem > 0 && 2 * rem <= G) ? 1 : 0; }
    __host__ __device__ __forceinline__ bool next(int i, Unit& u) const {
        long L = (long)i * G + c; u.half = 0;
        if (halves && L >= nfull) { if (L >= nfull + G) return false; L = nfull + (c >> 1); u.half = 1 + (c & 1); }
        if (L >= nwg) return false;
        int wgid = (int)L; { const int q = nwg / NXCD, r = nwg % NXCD, xcd = wgid % NXCD, off = wgid / NXCD; wgid = (xcd < r ? xcd * (q + 1) : r * (q + 1) + (xcd - r) * q) + off; }
        const int nig = WGM * nN, gid = wgid / nig, fm = gid * WGM, gsz = (nM - fm) < WGM ? (nM - fm) : WGM;
        u.pm = fm + ((wgid % nig) % gsz); u.pn = (wgid % nig) / gsz; return true;
    }
    __device__ __forceinline__ void a_ready(const Unit&) const {}
    __device__ __forceinline__ void done(const Unit&) const {}
};
__device__ __forceinline__ unsigned cvt_pk_bf16(float lo, float hi) { unsigned r; asm volatile("v_cvt_pk_bf16_f32 %0, %1, %2" : "=v"(r) : "v"(lo), "v"(hi)); return r; }
typedef float f32x2 __attribute__((ext_vector_type(2)));
__device__ __forceinline__ float silu_f(float x) { return x * __builtin_amdgcn_rcpf(1.0f + __expf(-x)); }
struct EpiSwiglu {
    static constexpr bool PERM = true, AFTER_DRAIN = false;
    bf16_t* O; int ldc, pad;
    __device__ __forceinline__ void operator()(const f32x4 (&acc)[2][2][4][2], const Unit& u, int wr, int wc, int fr, int fq) const {
        const int row0 = u.pm * BM + wr * 64 + fr + (u.half == 2 ? HALF : 0), col0 = u.pn * HALF + wc * 32 + 8 * fq;
#pragma unroll
        for (int ai = 0; ai < 2; ++ai) { if (ai == 1 && u.half) break;
#pragma unroll
            for (int m = 0; m < 4; ++m) { bf16_t* rowp = O + (size_t)(row0 + ai * HALF + m * 16) * ldc + col0;
                float r[8];
#pragma unroll
                for (int n = 0; n < 2; ++n)
#pragma unroll
                    for (int e = 0; e < 4; ++e) r[n * 4 + e] = silu_f(acc[ai][0][m][n][e]) * acc[ai][1][m][n][e];
                u32x4 w; w.x = cvt_pk_bf16(r[0], r[1]); w.y = cvt_pk_bf16(r[2], r[3]); w.z = cvt_pk_bf16(r[4], r[5]); w.w = cvt_pk_bf16(r[6], r[7]);
                *(u32x4*)rowp = w; } }
    }
};
struct EpiResid {
    static constexpr bool PERM = false, AFTER_DRAIN = false;
    float* X; const float* gate; int ldc, cond_stride; float coef; int pad;
    __device__ __forceinline__ void operator()(const f32x4 (&acc)[2][2][4][2], const Unit& u, int wr, int wc, int fr, int fq) const {
        const int row0 = u.pm * BM + wr * 64 + fr + (u.half == 2 ? HALF : 0), col0 = u.pn * BM + wc * 32 + 4 * fq;
        const int cond = u.pm < 16 ? 0 : (u.pm < 32 ? 1 : 2);
        const float* gp = gate + (size_t)cond * cond_stride + col0;
        f32x4 gv[2][2];
#pragma unroll
        for (int bj = 0; bj < 2; ++bj)
#pragma unroll
            for (int n = 0; n < 2; ++n) gv[bj][n] = *(const f32x4*)(gp + bj * HALF + n * 16) * coef;
#pragma unroll
        for (int ai = 0; ai < 2; ++ai) { if (ai == 1 && u.half) break;
#pragma unroll
            for (int m = 0; m < 4; ++m) { float* rowp = X + (size_t)(row0 + ai * HALF + m * 16) * ldc + col0;
#pragma unroll
                for (int bj = 0; bj < 2; ++bj)
#pragma unroll
                    for (int n = 0; n < 2; ++n) { f32x4* p = (f32x4*)(rowp + bj * HALF + n * 16); *p = *p + gv[bj][n] * acc[ai][bj][m][n]; } } }
    }
};
struct EpiResidTQ {
    static constexpr bool PERM = false, AFTER_DRAIN = false;
    float* X; const float* R0; const float* R1; const float* gate; int ldc, cond_stride; float coef; int pad;
    __device__ __forceinline__ void operator()(const f32x4 (&acc)[2][2][4][2], const Unit& u, int wr, int wc, int fr, int fq) const {
        const int rbase = u.pm * 192, col0 = u.pn * BM + wc * 32 + 4 * fq;
        constexpr int AI[6] = {0, 0, 0, 0, 1, 1}, MM[6] = {0, 1, 2, 3, 0, 1};
        int cur_cond; f32x4 gv[2][2];
        { const int rg0 = rbase + wr * 64; cur_cond = rg0 < 4096 ? 0 : (rg0 < 8192 ? 1 : 2); const float* gp = gate + (size_t)cur_cond * cond_stride + col0;
#pragma unroll
          for (int bj = 0; bj < 2; ++bj)
#pragma unroll
              for (int n = 0; n < 2; ++n) gv[bj][n] = *(const f32x4*)(gp + bj * HALF + n * 16) * coef; }
#pragma unroll
        for (int hb = 0; hb < 2; ++hb) {
            f32x4 xin[3][2][2];
#pragma unroll
            for (int q = 0; q < 3; ++q) { const int g = 3 * hb + q, rg = rbase + (AI[g] ? HALF + wr * 32 : wr * 64) + MM[g] * 16; const float* rowp = (rg < 4096 ? R0 + (size_t)(rg + fr) * ldc : R1 + (size_t)(rg + fr - 4096) * ldc) + col0;
#pragma unroll
                for (int bj = 0; bj < 2; ++bj)
#pragma unroll
                    for (int n = 0; n < 2; ++n) xin[q][bj][n] = *(const f32x4*)(rowp + bj * HALF + n * 16); }
#pragma unroll
            for (int q = 0; q < 3; ++q) { const int g = 3 * hb + q, rg = rbase + (AI[g] ? HALF + wr * 32 : wr * 64) + MM[g] * 16, cond = rg < 4096 ? 0 : (rg < 8192 ? 1 : 2);
                if (cond != cur_cond) { cur_cond = cond; const float* gp = gate + (size_t)cond * cond_stride + col0;
#pragma unroll
                    for (int bj = 0; bj < 2; ++bj)
#pragma unroll
                        for (int n = 0; n < 2; ++n) gv[bj][n] = *(const f32x4*)(gp + bj * HALF + n * 16) * coef; }
                float* rowp = X + (size_t)(rg + fr) * ldc + col0;
#pragma unroll
                for (int bj = 0; bj < 2; ++bj)
#pragma unroll
                    for (int n = 0; n < 2; ++n) *(f32x4*)(rowp + bj * HALF + n * 16) = xin[q][bj][n] + gv[bj][n] * acc[AI[g]][bj][MM[g]][n]; }
        }
    }
};
struct EpiProj {
    static constexpr bool PERM = true, AFTER_DRAIN = false;
    bf16_t* P; float* AB; float* CK; float* CV;
    __device__ __forceinline__ void operator()(const f32x4 (&acc)[2][2][4][2], const Unit& u, int wr, int wc, int fr, int fq) const {
        const int row0 = u.pm * BM + wr * 64 + fr + (u.half == 2 ? HALF : 0), col0 = u.pn * BM + wc * 32 + 8 * fq;
        if (u.pn < 22) {
            const bool cache = u.pm < 16 && u.pn >= 12 && u.pn < 20;
            float* cp = (u.pn < 16 ? CK : CV) + ((size_t)(u.pm * 2) * 256 + (row0 & 255)) * 1024 + (u.pn & 3) * 256 + wc * 32 + 8 * fq;
            bf16_t* rowp = P + (size_t)row0 * 5632 + col0;
#pragma unroll
            for (int ai = 0; ai < 2; ++ai) { if (ai == 1 && u.half) break;
#pragma unroll
                for (int m = 0; m < 4; ++m) {
#pragma unroll
                    for (int bj = 0; bj < 2; ++bj) { const f32x4 v0 = acc[ai][bj][m][0], v1 = acc[ai][bj][m][1];
                        u32x4 w; w.x = cvt_pk_bf16(v0[0], v0[1]); w.y = cvt_pk_bf16(v0[2], v0[3]); w.z = cvt_pk_bf16(v1[0], v1[1]); w.w = cvt_pk_bf16(v1[2], v1[3]);
                        *(u32x4*)(rowp + bj * HALF) = w;
                        if (cache) { *(f32x4*)(cp + bj * HALF) = v0; *(f32x4*)(cp + bj * HALF + 4) = v1; } }
                    rowp += (m == 3 ? (HALF - 48) : 16) * 5632; cp += (m == 3 ? (HALF - 48) : 16) * 1024; asm volatile("" : "+v"(rowp), "+v"(cp)); } }
        } else {
            if (wc == 0 && fq < 2) {
#pragma unroll
                for (int ai = 0; ai < 2; ++ai) { if (ai == 1 && u.half) break;
#pragma unroll
                    for (int m = 0; m < 4; ++m) { float* rowp = AB + (size_t)(row0 + ai * HALF + m * 16) * 16 + 8 * fq;
                        *(f32x4*)rowp = acc[ai][0][m][0]; *(f32x4*)(rowp + 4) = acc[ai][0][m][1]; } }
            }
        }
    }
};
template <class Epi, class Sched, bool ALIGN_EPI = false, bool SP2 = false, bool TQ = false>
__device__ __forceinline__ void gemm_phase(PG8_LAS unsigned char* lds, const Gemm g, const Sched& S, const Epi& E, const int tid) {
    const int wid = __builtin_amdgcn_readfirstlane(tid >> 6), lane = tid & 63, wr = wid >> 2, wc = wid & 3, fr = lane & 15, fq = lane >> 4;
    const int K = g.K, nt = K / BK;
    unsigned voffA[2], voffB[2];
#pragma unroll
    for (int i = 0; i < 2; ++i) { int R, C; stage_rc(tid * 16 + i * 8192, R, C); const int Rb = Epi::PERM ? ((R & ~31) + perm32(R & 31)) : R;
        voffA[i] = (unsigned)(R * K + C) * 2u; voffB[i] = (unsigned)(Rb * K + C) * 2u; }
    const size_t kstep = (size_t)(BK * 2);
    const size_t hstep = (size_t)HALF * K * 2;
    const size_t tstep = 2 * hstep;
    const size_t tstepA = TQ ? (size_t)192 * K * 2 : tstep;
    const unsigned ldsw = (unsigned)wid * 1024u;
    const int aoff = lds_byte(wr * 64 + fr, fq * 8), boff = lds_byte(wc * 32 + fr, fq * 8);
    const int aoff1 = TQ ? lds_byte(wr * 32 + fr, fq * 8) : aoff;
#define PG8_SA(b, h) (((b) * 2 + (h)) * HTB)
#define PG8_SB(b, h) ((4 + (b) * 2 + (h)) * HTB)
#define PG8_STAGE(bufoff, gbase, voff) do { _Pragma("unroll") for (int _i = 0; _i < 2; ++_i) \
        __builtin_amdgcn_global_load_lds((const unsigned*)((const char*)(gbase) + (voff)[_i]), (PG8_LAS unsigned*)(lds + (bufoff) + ldsw + _i * 8192), 16, 0, 0); } while (0)
#define PG8_STAGE_A1(bufoff, gbase, voff) do { if constexpr (TQ) __builtin_amdgcn_global_load_lds((const unsigned*)((const char*)(gbase) + (voff)[0]), (PG8_LAS unsigned*)(lds + (bufoff) + ldsw), 16, 0, 0); else PG8_STAGE(bufoff, gbase, voff); } while (0)
#define PG8_LDA(dst, b, h) do { _Pragma("unroll") for (int m = 0; m < 4; ++m) _Pragma("unroll") for (int k = 0; k < 2; ++k) dst[m][k] = *(const PG8_LAS bf16x8*)(lds + PG8_SA(b, h) + aoff + m * 2048 + k * 1024); } while (0)
#define PG8_LDA2(dst, b, h) do { if constexpr (TQ) { _Pragma("unroll") for (int m = 0; m < 2; ++m) _Pragma("unroll") for (int k = 0; k < 2; ++k) dst[m][k] = *(const PG8_LAS bf16x8*)(lds + PG8_SA(b, h) + aoff1 + m * 2048 + k * 1024); } else PG8_LDA(dst, b, h); } while (0)
#define PG8_LDB(dst, b, h) do { _Pragma("unroll") for (int n = 0; n < 2; ++n) _Pragma("unroll") for (int k = 0; k < 2; ++k) dst[n][k] = *(const PG8_LAS bf16x8*)(lds + PG8_SB(b, h) + boff + n * 2048 + k * 1024); } while (0)
#define PG8_MMA(ai, bj, At, Bt) do { __builtin_amdgcn_s_setprio(1); _Pragma("unroll") for (int m = 0; m < 4; ++m) _Pragma("unroll") for (int n = 0; n < 2; ++n) _Pragma("unroll") for (int k = 0; k < 2; ++k) \
        acc[ai][bj][m][n] = __builtin_amdgcn_mfma_f32_16x16x32_bf16(Bt[n][k], At[m][k], acc[ai][bj][m][n], 0, 0, 0); __builtin_amdgcn_s_setprio(0); } while (0)
#define PG8_MMA2(ai, bj, At, Bt) do { if constexpr (TQ) { __builtin_amdgcn_s_setprio(1); _Pragma("unroll") for (int m = 0; m < 2; ++m) _Pragma("unroll") for (int n = 0; n < 2; ++n) _Pragma("unroll") for (int k = 0; k < 2; ++k) \
        acc[ai][bj][m][n] = __builtin_amdgcn_mfma_f32_16x16x32_bf16(Bt[n][k], At[m][k], acc[ai][bj][m][n], 0, 0, 0); __builtin_amdgcn_s_setprio(0); } else PG8_MMA(ai, bj, At, Bt); } while (0)
#define PG8_WAIT_V(n) asm volatile("s_waitcnt vmcnt(" #n ")" ::: "memory")
#define PG8_WAIT_V8 do { if constexpr (TQ) PG8_WAIT_V(7); else PG8_WAIT_V(8); } while (0)
#define PG8_WAIT_L(n) asm volatile("s_waitcnt lgkmcnt(" #n ")" ::: "memory")
#define PG8_BAR __builtin_amdgcn_s_barrier()
#define PG8_SCHED __builtin_amdgcn_sched_barrier(0)
    Unit cur, nxt; int ui = 0;
    if (!S.next(0, cur)) return;
    f32x4 acc[2][2][4][2];
#pragma unroll
    for (int a = 0; a < 2; ++a)
#pragma unroll
        for (int b = 0; b < 2; ++b)
#pragma unroll
            for (int m = 0; m < 4; ++m)
#pragma unroll
                for (int n = 0; n < 2; ++n) acc[a][b][m][n] = (f32x4){0.f, 0.f, 0.f, 0.f};
    bf16x8 At[4][2], B0[2][2], B1[2][2];
    const char* cA = (const char*)g.A + (size_t)cur.pm * tstepA + (cur.half == 2 ? hstep : 0); const char* cB = (const char*)g.Bt + (size_t)cur.pn * tstep; size_t hA = cur.half ? 0 : hstep;
    S.a_ready(cur);
    if constexpr (SP2) {
        PG8_STAGE(PG8_SB(0, 0), cB, voffB); PG8_STAGE(PG8_SB(0, 1), cB + hstep, voffB); PG8_STAGE(PG8_SA(0, 0), cA, voffA); PG8_STAGE_A1(PG8_SA(0, 1), cA + hA, voffA);
        if (wr == 1) PG8_BAR;
        if constexpr (TQ) PG8_WAIT_V(1); else PG8_WAIT_V(2); PG8_BAR;
        PG8_STAGE(PG8_SB(1, 0), cB + kstep, voffB); PG8_STAGE(PG8_SA(1, 0), cA + kstep, voffA); PG8_STAGE(PG8_SB(1, 1), cB + hstep + kstep, voffB);
        PG8_WAIT_V(6); PG8_BAR;
    } else {
        PG8_STAGE(PG8_SB(0, 0), cB, voffB); PG8_STAGE(PG8_SA(0, 0), cA, voffA); PG8_STAGE(PG8_SB(0, 1), cB + hstep, voffB); PG8_STAGE(PG8_SA(0, 1), cA + hstep, voffA);
        if (wr == 1) PG8_BAR;
        PG8_WAIT_V(4); PG8_BAR;
        PG8_STAGE(PG8_SB(1, 0), cB + kstep, voffB); PG8_STAGE(PG8_SA(1, 0), cA + kstep, voffA); PG8_STAGE(PG8_SB(1, 1), cB + hstep + kstep, voffB);
        PG8_WAIT_V(6); PG8_BAR;
    }
    for (;;) {
        const bool has_next = S.next(ui + 1, nxt);
        const char* nA = has_next ? (const char*)g.A + (size_t)nxt.pm * tstepA + (nxt.half == 2 ? hstep : 0) : cA; const char* nB = has_next ? (const char*)g.Bt + (size_t)nxt.pn * tstep : cB;
        const size_t nhA = has_next ? (nxt.half ? 0 : hstep) : hA; const bool whole = cur.half == 0;
        for (int t = 0; t < nt; t += 2) {
            const bool last = (t == nt - 2);
            const char* a1 = cA + (size_t)(t + 1) * kstep;
            const char* a2 = last ? nA : cA + (size_t)(t + 2) * kstep; const char* b2 = last ? nB : cB + (size_t)(t + 2) * kstep;
            const char* a3 = a2 + kstep; const char* b3 = b2 + kstep;
            if (last && has_next) S.a_ready(nxt);
            if constexpr (SP2) {
            PG8_LDB(B0, 0, 0); PG8_LDB(B1, 0, 1); PG8_SCHED; PG8_LDA(At, 0, 0); PG8_STAGE_A1(PG8_SA(1, 1), a1 + hA, voffA);
            PG8_WAIT_V8; PG8_WAIT_L(0); PG8_BAR; PG8_MMA(0, 0, At, B0); PG8_MMA(0, 1, At, B1); PG8_BAR; PG8_SCHED;
            if (whole) PG8_LDA2(At, 0, 1); PG8_STAGE(PG8_SB(0, 0), b2, voffB); PG8_STAGE(PG8_SB(0, 1), b2 + hstep, voffB); PG8_STAGE(PG8_SA(0, 0), a2, voffA);
            PG8_WAIT_V8; PG8_WAIT_L(0); PG8_BAR; if (whole) { PG8_MMA2(1, 0, At, B0); PG8_MMA2(1, 1, At, B1); } PG8_BAR; PG8_SCHED;
            PG8_LDB(B0, 1, 0); PG8_LDB(B1, 1, 1); PG8_SCHED; PG8_LDA(At, 1, 0); PG8_STAGE_A1(PG8_SA(0, 1), a2 + (last ? nhA : hA), voffA);
            PG8_WAIT_V8; PG8_WAIT_L(0); PG8_BAR; PG8_MMA(0, 0, At, B0); PG8_MMA(0, 1, At, B1); PG8_BAR; PG8_SCHED;
            if (whole) PG8_LDA2(At, 1, 1); PG8_STAGE(PG8_SB(1, 0), b3, voffB); PG8_STAGE(PG8_SB(1, 1), b3 + hstep, voffB); PG8_STAGE(PG8_SA(1, 0), a3, voffA);
            PG8_WAIT_V8; PG8_WAIT_L(0); PG8_BAR; if (whole) { PG8_MMA2(1, 0, At, B0); PG8_MMA2(1, 1, At, B1); } PG8_BAR; PG8_SCHED;
            } else {
            PG8_LDB(B0, 0, 0); PG8_SCHED; PG8_LDA(At, 0, 0); PG8_STAGE(PG8_SA(1, 1), a1 + hstep, voffA);
            PG8_WAIT_L(8); PG8_BAR; PG8_WAIT_L(0); PG8_MMA(0, 0, At, B0); PG8_BAR; PG8_SCHED;
            PG8_LDB(B1, 0, 1); PG8_STAGE(PG8_SB(0, 0), b2, voffB);
            PG8_BAR; PG8_WAIT_L(0); PG8_MMA(0, 1, At, B1); PG8_BAR;
            PG8_LDA(At, 0, 1); PG8_STAGE(PG8_SA(0, 0), a2, voffA);
            PG8_BAR; PG8_WAIT_L(0); PG8_MMA(1, 0, At, B0); PG8_BAR; PG8_SCHED;
            PG8_STAGE(PG8_SB(0, 1), b2 + hstep, voffB);
            PG8_WAIT_V(6); PG8_BAR; PG8_MMA(1, 1, At, B1); PG8_BAR;
            PG8_LDB(B0, 1, 0); PG8_SCHED; PG8_LDA(At, 1, 0); PG8_STAGE(PG8_SA(0, 1), a2 + hstep, voffA);
            PG8_WAIT_L(8); PG8_BAR; PG8_WAIT_L(0); PG8_MMA(0, 0, At, B0); PG8_BAR; PG8_SCHED;
            PG8_LDB(B1, 1, 1); PG8_STAGE(PG8_SB(1, 0), b3, voffB);
            PG8_BAR; PG8_WAIT_L(0); PG8_MMA(0, 1, At, B1); PG8_BAR;
            PG8_LDA(At, 1, 1); PG8_STAGE(PG8_SA(1, 0), a3, voffA);
            PG8_BAR; PG8_WAIT_L(0); PG8_MMA(1, 0, At, B0); PG8_BAR; PG8_SCHED;
            PG8_STAGE(PG8_SB(1, 1), b3 + hstep, voffB);
            PG8_WAIT_V(6); PG8_BAR; PG8_MMA(1, 1, At, B1); PG8_BAR;
            }
        }
        if constexpr (ALIGN_EPI) { if (wr == 0) PG8_BAR; }
        if constexpr (!Epi::AFTER_DRAIN) { E(acc, cur, wr, wc, fr, fq); S.done(cur); }
        if (!has_next) break;
#pragma unroll
        for (int a = 0; a < 2; ++a)
#pragma unroll
            for (int b = 0; b < 2; ++b)
#pragma unroll
                for (int m = 0; m < 4; ++m)
#pragma unroll
                    for (int n = 0; n < 2; ++n) acc[a][b][m][n] = (f32x4){0.f, 0.f, 0.f, 0.f};
        cur = nxt; cA = nA; cB = nB; hA = nhA; ++ui;
        if constexpr (ALIGN_EPI) { if (wr == 1) PG8_BAR; }
    }
    PG8_WAIT_V(0);
    if constexpr (!ALIGN_EPI) { if (wr == 0) PG8_BAR; }
    PG8_BAR;
    if constexpr (Epi::AFTER_DRAIN) { E.fused(acc, cur, wr, wc, fr, fq, lds, wid, lane); S.done(cur); }
#undef PG8_SA
#undef PG8_SB
#undef PG8_STAGE
#undef PG8_LDA
#undef PG8_LDB
#undef PG8_MMA
#undef PG8_WAIT_V
#undef PG8_WAIT_L
#undef PG8_BAR
#undef PG8_SCHED
}
}
#define GAS __attribute__((address_space(1)))
#define XB_TMO      128
#define XB_XCNT(j)  (256  + 64 * (j))
#define XB_XSUB(j)  (1280 + 64 * (j))
#define XB_XGEN(j)  (2304 + 64 * (j))
#define XB_TOP      3328
#define XB_TOPGEN   3392
#define XCD_BAR_WORDS 3456
#define XB_SPIN_CAP (1u << 18)
#define LAS __attribute__((address_space(3)))

__device__ __forceinline__ unsigned xb_ld(unsigned* p)              { return __hip_atomic_load(p, __ATOMIC_RELAXED, __HIP_MEMORY_SCOPE_AGENT); }
__device__ __forceinline__ unsigned xb_add(unsigned* p, unsigned v) { return __hip_atomic_fetch_add(p, v, __ATOMIC_RELAXED, __HIP_MEMORY_SCOPE_AGENT); }
__device__ __forceinline__ unsigned xb_xcc_id() { return (unsigned)__builtin_amdgcn_s_getreg((3 << 11) | 20) & 0xFu; }
#define XB_SPIN(cond, bar) do { unsigned _sp = 0; while (cond) { __builtin_amdgcn_s_sleep(1); \
    if ((++_sp & 255u) == 0u) { if (xb_ld(&(bar)[XB_TMO])) break; if (_sp > XB_SPIN_CAP) { atomicAdd(&(bar)[XB_TMO], 1u); break; } } } } while (0)

struct XcdBarrier {
    unsigned* bar; unsigned x;
    volatile LAS unsigned* st;
};

__device__ __forceinline__ XcdBarrier xcd_barrier_post(unsigned* bar, volatile LAS unsigned* st) {
    XcdBarrier b; b.bar = bar; b.x = xb_xcc_id(); b.st = st;
    if (threadIdx.x == 0) (void)xb_add(&bar[XB_XCNT(b.x)], 1u);
    return b;
}
__device__ __forceinline__ void xcd_barrier_complete(unsigned* bar, unsigned x, unsigned& nloc, unsigned& nx) {
    const unsigned G = gridDim.x * gridDim.y * gridDim.z;
    unsigned sum, cnt, mine, sp = 0u;
    for (;;) {
        sum = 0u; cnt = 0u; mine = 0u;
#pragma unroll
        for (unsigned j = 0; j < 16; ++j) { const unsigned c = xb_ld(&bar[XB_XCNT(j)]); sum += c; cnt += (c > 0u) ? 1u : 0u; mine = (j == x) ? c : mine; }
        if (sum == G) break;
        __builtin_amdgcn_s_sleep(1);
        if ((++sp & 255u) == 0u) { if (xb_ld(&bar[XB_TMO])) break; if (sp > XB_SPIN_CAP) { atomicAdd(&bar[XB_TMO], 1u); break; } }
    }
    nloc = mine > 0u ? mine : 1u; nx = cnt > 0u ? cnt : 1u;
}

__device__ __forceinline__ void xcd_barrier(const XcdBarrier& b, const int tid_) {
    asm volatile("s_waitcnt vmcnt(0)" ::: "memory");
    __syncthreads();
    if (tid_ == 0) {
        unsigned* bar = b.bar;
        __builtin_amdgcn_s_waitcnt(0);
        unsigned nloc = b.st[0], nx = b.st[1];
        if (nloc == 0u) { xcd_barrier_complete(bar, b.x, nloc, nx); b.st[0] = nloc; b.st[1] = nx; }
        const unsigned old = xb_add(&bar[XB_XSUB(b.x)], 1u);
        const unsigned gen = old / nloc;
        if (old + 1u == (gen + 1u) * nloc) {
            __builtin_amdgcn_fence(__ATOMIC_RELEASE, "agent");
            asm volatile("s_waitcnt vmcnt(0)" ::: "memory");
            const unsigned og = xb_add(&bar[XB_TOP], 1u);
            const unsigned tg = og / nx;
            if (og + 1u == (tg + 1u) * nx) xb_add(&bar[XB_TOPGEN], 1u);
            else XB_SPIN(xb_ld(&bar[XB_TOPGEN]) == tg, bar);
            __builtin_amdgcn_fence(__ATOMIC_ACQUIRE, "agent");
            xb_add(&bar[XB_XGEN(b.x)], 1u);
            asm volatile("s_waitcnt vmcnt(0)" ::: "memory");
        } else {
            XB_SPIN(xb_ld(&bar[XB_XGEN(b.x)]) == gen, bar);
            __builtin_amdgcn_fence(__ATOMIC_ACQUIRE, "agent");
            asm volatile("s_waitcnt vmcnt(0)" ::: "memory");
        }
    }
    __syncthreads();
}

typedef unsigned short bf16_t;
typedef unsigned u32x4_t __attribute__((ext_vector_type(4)));
typedef float f32x4_t __attribute__((ext_vector_type(4)));
constexpr int D = 2048, MCTX = 4096, MLAT = 8192, M = MCTX + MLAT, DFF = 5632, NFF = 2 * DFF, PROJW = 5632, NPROJ = 5888, IN_COLS = 5648, ADA_N = 9 * D;
constexpr int DEPTH = 2, PAST = 512, LK_LAT = PAST + 4096;
constexpr float EPS = 1e-6f;
constexpr size_t MiB = 1u << 20;
constexpr size_t WS_CTL = 0, CTL_BYTES = 1 * MiB, WS_ADA = 1 * MiB, ADA_BYTES = (size_t)2 * 3 * ADA_N * 4, WS_LAM = 2 * MiB, WS_W = 16 * MiB;
constexpr size_t W_1IN = 0, W_1OUT = W_1IN + (size_t)NFF * D * 2, W_2IN = W_1OUT + (size_t)D * DFF * 2, W_2OUT = W_2IN + (size_t)NFF * D * 2, W_IN = W_2OUT + (size_t)D * DFF * 2,
                 W_OUT = W_IN + (size_t)NPROJ * D * 2, W_LAYER = W_OUT + (size_t)D * D * 2;
static_assert(WS_W + 2 * W_LAYER <= 344 * MiB, "weights");
constexpr size_t WS_X = 344 * MiB, WS_H = 440 * MiB, WS_CAT = 488 * MiB, WS_ACT = 536 * MiB, WS_PROJ = 668 * MiB, WS_AB = 800 * MiB, WS_GQ = 801 * MiB, WS_GK = 825 * MiB, WS_GV = 849 * MiB,
                 WS_GG = 873 * MiB, WS_GB = WS_GG + 512 * 1024, WS_OF = 874 * MiB, WS_OB = 898 * MiB, WS_QB = 922 * MiB, WS_KB = 938 * MiB, WS_VTL = 956 * MiB, WS_VTC = 1112 * MiB, WS_END = 1120 * MiB;
constexpr size_t OUT_YP = 0, OUT_YS = 8388608, OUT_CK = 25165824, OUT_CV = 33554432, OUT_ST = 41943040, OUT_TOTAL = 46137344;
constexpr int CW_BAR = 4096, CW_QUEUE = 16384;
constexpr int LDS_MISC = 147200, LDS_BYTES = 147456;
constexpr int NWAVES = 8;

__device__ __forceinline__ float bf2f(bf16_t b) { return __uint_as_float(((unsigned)b) << 16); }
__device__ __forceinline__ unsigned f2bf(float f) { unsigned u = __float_as_uint(f); return (u + 0x7fffu + ((u >> 16) & 1u)) >> 16; }
__device__ __forceinline__ unsigned pk2(float lo, float hi) { return f2bf(lo) | (f2bf(hi) << 16); }
__device__ __forceinline__ float lane_get(float v, int src_lane) { return __int_as_float(__builtin_amdgcn_ds_bpermute(src_lane << 2, __float_as_int(v))); }
__device__ __forceinline__ float wave_sum(float v, int lane) {
#pragma unroll
    for (int o = 1; o < 64; o <<= 1) v += lane_get(v, lane ^ o);
    return v;
}
__device__ __forceinline__ float silu(float x) { return x * __builtin_amdgcn_rcpf(1.0f + __expf(-x)); }
#define LDS_WAIT() asm volatile("s_waitcnt lgkmcnt(0)" ::: "memory")
__device__ __forceinline__ void row_geom(int row, int& seq0, int& L, int& t) { if (row < MCTX) { seq0 = row & ~255; L = 256; t = row & 255; } else { const int r = row - MCTX; seq0 = MCTX + (r & ~4095); L = 4096; t = r & 4095; } }

__device__ __forceinline__ int fresh_tid_w(int wave_s) { int t; asm volatile("v_mbcnt_lo_u32_b32 %0, -1, 0\n\tv_mbcnt_hi_u32_b32 %0, -1, %0" : "=v"(t)); return wave_s * 64 + t; }
struct Args { const float* in[27]; float* out; unsigned char* ws; };
struct Ptrs {
    const float *x_prompt, *x_sample, *c, *cache_k, *cache_v, *state_gdn, *c_ctx, *w_ada, *b_ada, *norm_ffn1, *ffn1_in, *ffn1_out, *norm_mix, *w_in, *gdn_conv, *gdn_a_log, *gdn_dt_bias, *gdn_norm,
                *diff_lam, *diff_norm, *pool_w, *pool_scale, *w_out, *norm_ffn2, *ffn2_in, *ffn2_out, *final_norm;
};

__device__ __forceinline__ int colmap(int mode, int n) {
    if (mode == 1) { const int t = n >> 8, r = n & 255; return r < 128 ? 128 * t + r : DFF + 128 * t + (r - 128); }
    if (mode == 2) { return n < 2048 ? n : (n < 5632 ? n + 16 : (n < 5648 ? 2048 + (n - 5632) : -1)); }
    return n;
}
typedef float f32x2pf_t __attribute__((ext_vector_type(2)));
__device__ __forceinline__ void tr_item(const float* __restrict__ src, int ld, bf16_t* __restrict__ dst, int Kdst, int mode, int item, int nblk, LAS float* scr, int lane,
                                        const float* __restrict__ pool_w, const float* __restrict__ pool_scale) {
    const int kb = item / nblk, nb = item - kb * nblk, k0 = 64 * kb, n0 = 32 * nb, nn = lane & 31, kh = lane >> 5;
    if (mode == 3 && k0 >= 1536) {
        const int gc0 = k0 - 1536, g = gc0 >> 7, ml = lane & 15, kq = lane >> 4;
        f32x4_t acc[4][2];
#pragma unroll
        for (int mt = 0; mt < 4; ++mt) { acc[mt][0] = (f32x4_t){0.f, 0.f, 0.f, 0.f}; acc[mt][1] = (f32x4_t){0.f, 0.f, 0.f, 0.f}; }
        const float* Ab = pool_w + (size_t)(gc0 + ml) * 128 + 4 * kq; const float* Sb = pool_scale + g * 128 + 4 * kq; const float* Bb = src + (size_t)(1536 + g * 128 + 4 * kq) * ld + n0 + 2 * ml;
#pragma unroll
        for (int s = 0; s < 8; ++s) { const f32x4_t sc4 = *(const f32x4_t*)(Sb + 16 * s); f32x4_t a4[4]; f32x2pf_t b2[4];
#pragma unroll
            for (int mt = 0; mt < 4; ++mt) a4[mt] = *(const f32x4_t*)(Ab + (size_t)mt * 16 * 128 + 16 * s) * sc4;
#pragma unroll
            for (int e = 0; e < 4; ++e) b2[e] = *(const f32x2pf_t*)(Bb + (size_t)(16 * s + e) * ld);
#pragma unroll
            for (int e = 0; e < 4; ++e)
#pragma unroll
                for (int mt = 0; mt < 4; ++mt) { acc[mt][0] = __builtin_amdgcn_mfma_f32_16x16x4f32(a4[mt][e], b2[e].x, acc[mt][0], 0, 0, 0); acc[mt][1] = __builtin_amdgcn_mfma_f32_16x16x4f32(a4[mt][e], b2[e].y, acc[mt][1], 0, 0, 0); } }
#pragma unroll
        for (int mt = 0; mt < 4; ++mt)
#pragma unroll
            for (int e = 0; e < 4; ++e) { scr[(16 * mt + 4 * kq + e) * 33 + 2 * ml] = acc[mt][0][e]; scr[(16 * mt + 4 * kq + e) * 33 + 2 * ml + 1] = acc[mt][1][e]; }
    } else {
        const int sc = colmap(mode == 3 ? 0 : mode, n0 + nn);
        float v[32];
#pragma unroll
        for (int i = 0; i < 32; ++i) v[i] = sc >= 0 ? __builtin_nontemporal_load(src + (size_t)(k0 + 2 * i + kh) * ld + sc) : 0.f;
#pragma unroll
        for (int i = 0; i < 32; ++i) scr[(2 * i + kh) * 33 + nn] = v[i];
    }
    LDS_WAIT();
    const int c = lane & 7;
#pragma unroll
    for (int j = 0; j < 4; ++j) { const int n = (lane >> 3) + 8 * j; const LAS float* s = scr + (8 * c) * 33 + n;
        u32x4_t o; o.x = pk2(s[0 * 33], s[1 * 33]); o.y = pk2(s[2 * 33], s[3 * 33]); o.z = pk2(s[4 * 33], s[5 * 33]); o.w = pk2(s[6 * 33], s[7 * 33]);
        *(u32x4_t*)(dst + (size_t)(n0 + n) * Kdst + k0 + 8 * c) = o; }
    LDS_WAIT();
}
constexpr int I_FIN = (D / 64) * (NFF / 32), I_FOUT = (DFF / 64) * (D / 32), I_WIN = (D / 64) * (NPROJ / 32), I_WOUT = (D / 64) * (D / 32), I_LAYER = 2 * I_FIN + 2 * I_FOUT + I_WIN + I_WOUT;
constexpr int DEFER_T = 8, SEG_F = 1024 * DEFER_T, SEG_W = 768 * DEFER_T, DEFER_ALL = I_LAYER - 512;
constexpr int DSEG0 = 0, DSEG1 = SEG_F, DSEG2 = SEG_F + SEG_W, DSEG3 = 2 * SEG_F + SEG_W, DSEG4 = 3 * SEG_F + SEG_W, DSEG5 = 3 * SEG_F + 2 * SEG_W, DSEG6 = DEFER_ALL;
constexpr int DM1 = I_FIN, DM2 = DM1 + I_FOUT, DM3 = DM2 + I_WIN, DM4 = DM3 + I_FIN, DM5 = DM4 + 1536;
static_assert(DSEG5 <= DSEG6 && DSEG6 - DSEG5 <= SEG_F, "last segment fits its tail");
static_assert(DM1 <= DSEG3, "layer 1 ffn1_in is complete after layer 0");
static_assert(DM2 <= DSEG4 && DM3 <= DSEG4, "ffn1_out and w_in are complete after layer 1's FFN1-in tail");
static_assert(DM4 <= DSEG5 && DM5 <= DSEG5, "ffn2_in and w_out are complete after layer 1's w_in tail");
__device__ __forceinline__ void ph_prologue(const Ptrs& p, unsigned char* ws, LAS unsigned char* lds, int gw, int NGW, int wave, int lane, int tid) {
    LAS float* sc = (LAS float*)lds;
    for (int i = tid; i < 3 * D; i += NWAVES * 64) { const int ci = i >> 11, k = i & 2047; sc[i] = silu(ci == 0 ? p.c_ctx[k] : p.c[(ci - 1) * D + k]); }
    __syncthreads();
    float* ada = (float*)(ws + WS_ADA);
    for (int it = gw; it < 2 * 144 * 32; it += NGW) {
        const int l = it / 4608, r = it - l * 4608, jb = r >> 5, ks = r & 31, j = jb * 128 + 2 * lane;
        const float* w = p.w_ada + ((size_t)l * D + ks * 64) * ADA_N + j;
        f32x2pf_t a0 = {0.f, 0.f}, a1 = {0.f, 0.f}, a2 = {0.f, 0.f};
#pragma unroll 16
        for (int k = 0; k < 64; ++k) { const f32x2pf_t wv = __builtin_nontemporal_load((const f32x2pf_t*)(w + (size_t)k * ADA_N)); a0 += wv * sc[ks * 64 + k]; a1 += wv * sc[D + ks * 64 + k]; a2 += wv * sc[2 * D + ks * 64 + k]; }
        if (ks == 0) { const f32x2pf_t b = *(const f32x2pf_t*)(p.b_ada + l * ADA_N + j); a0 += b; a1 += b; a2 += b; }
        float* o = ada + (size_t)l * 3 * ADA_N + j;
        atomicAdd(o, a0.x); atomicAdd(o + 1, a0.y); atomicAdd(o + ADA_N, a1.x); atomicAdd(o + ADA_N + 1, a1.y); atomicAdd(o + 2 * ADA_N, a2.x); atomicAdd(o + 2 * ADA_N + 1, a2.y);
    }
    if (gw == 0) {
        float* lam = (float*)(ws + WS_LAM);
        for (int l = 0; l < DEPTH; ++l) { const float* v = p.diff_lam + l * 256;
            const float s1 = wave_sum(v[lane] * v[64 + lane], lane), s2 = wave_sum(v[128 + lane] * v[192 + lane], lane);
            const float lam_init = 0.8f - 0.6f * expf(-0.3f * (float)l);
            if (lane == 0) { lam[l * 2] = expf(s1) - expf(s2) + lam_init; lam[l * 2 + 1] = lam_init; } }
    }
    LAS float* scr = (LAS float*)(lds + 24576 + wave * 8448);
    const int skip = NGW == 256 * NWAVES ? DEFER_ALL : 0;
    for (int it = gw; it < 2 * I_LAYER - skip; it += NGW) {
        const int l = it >= I_LAYER ? 1 : 0; int r = l ? it - I_LAYER + skip : it; unsigned char* Wl = ws + WS_W + (size_t)l * W_LAYER;
        if (r < I_FIN) { tr_item(p.ffn1_in + (size_t)l * D * NFF, NFF, (bf16_t*)(Wl + W_1IN), D, 1, r, NFF / 32, scr, lane, nullptr, nullptr); continue; } r -= I_FIN;
        if (r < I_FIN) { tr_item(p.ffn2_in + (size_t)l * D * NFF, NFF, (bf16_t*)(Wl + W_2IN), D, 1, r, NFF / 32, scr, lane, nullptr, nullptr); continue; } r -= I_FIN;
        if (r < I_FOUT) { tr_item(p.ffn1_out + (size_t)l * DFF * D, D, (bf16_t*)(Wl + W_1OUT), DFF, 0, r, D / 32, scr, lane, nullptr, nullptr); continue; } r -= I_FOUT;
        if (r < I_FOUT) { tr_item(p.ffn2_out + (size_t)l * DFF * D, D, (bf16_t*)(Wl + W_2OUT), DFF, 0, r, D / 32, scr, lane, nullptr, nullptr); continue; } r -= I_FOUT;
        if (r < I_WIN) { tr_item(p.w_in + (size_t)l * D * IN_COLS, IN_COLS, (bf16_t*)(Wl + W_IN), D, 2, r, NPROJ / 32, scr, lane, nullptr, nullptr); continue; } r -= I_WIN;
        tr_item(p.w_out + (size_t)l * D * D, D, (bf16_t*)(Wl + W_OUT), D, 3, r, D / 32, scr, lane, p.pool_w + (size_t)l * 4 * 128 * 128, p.pool_scale + (size_t)l * 512);
    }
}
__device__ __forceinline__ void norm_row(const float* __restrict__ xrow, int row, const float* __restrict__ gain, const float* __restrict__ shift, const float* __restrict__ scale, bf16_t* __restrict__ H, float* xcopy, int lane) {
    const int cond = row < MCTX ? 0 : (row < MCTX + 4096 ? 1 : 2);
    const f32x4_t* xr = (const f32x4_t*)xrow + lane;
    const f32x4_t* gp = (const f32x4_t*)gain + lane; const f32x4_t* sh = (const f32x4_t*)(shift + (size_t)cond * ADA_N) + lane; const f32x4_t* sc = (const f32x4_t*)(scale + (size_t)cond * ADA_N) + lane;
    f32x4_t v[8], gq[8], aq[8], bq[8]; float ss = 0.f;
#pragma unroll
    for (int j = 0; j < 8; ++j) v[j] = xr[64 * j];
#pragma unroll
    for (int j = 0; j < 8; ++j) { gq[j] = gp[64 * j]; aq[j] = sh[64 * j]; bq[j] = sc[64 * j]; }
#pragma unroll
    for (int j = 0; j < 8; ++j) ss += (v[j].x * v[j].x + v[j].y * v[j].y) + (v[j].z * v[j].z + v[j].w * v[j].w);
    const float rstd = rsqrtf(wave_sum(ss, lane) * (1.0f / D) + EPS);
    if (xcopy) { f32x4_t* xc = (f32x4_t*)(xcopy + (size_t)row * D) + lane;
#pragma unroll
        for (int j = 0; j < 8; ++j) xc[64 * j] = v[j]; }
    unsigned long long* o8 = (unsigned long long*)(H + (size_t)row * D) + lane;
#pragma unroll
    for (int j = 0; j < 8; ++j) { const f32x4_t g = gq[j], a = aq[j], b = bq[j]; const f32x4_t y = v[j] * rstd * g * (b + 1.0f) + a;
        o8[64 * j] = (unsigned long long)pk2(y.x, y.y) | ((unsigned long long)pk2(y.z, y.w) << 32); }
}
__device__ __forceinline__ void final_norm_row(const float* __restrict__ X, int row, const float* __restrict__ gain, float* __restrict__ out, int lane) {
    const f32x4_t* xr = (const f32x4_t*)(X + (size_t)row * D) + lane; const f32x4_t* gp = (const f32x4_t*)gain + lane;
    f32x4_t v[8], gq[8]; float ss = 0.f;
#pragma unroll
    for (int j = 0; j < 8; ++j) v[j] = xr[64 * j];
#pragma unroll
    for (int j = 0; j < 8; ++j) gq[j] = gp[64 * j];
#pragma unroll
    for (int j = 0; j < 8; ++j) ss += (v[j].x * v[j].x + v[j].y * v[j].y) + (v[j].z * v[j].z + v[j].w * v[j].w);
    const float rstd = rsqrtf(wave_sum(ss, lane) * (1.0f / D) + EPS);
    f32x4_t* o = (f32x4_t*)(out + (size_t)row * D) + lane;
#pragma unroll
    for (int j = 0; j < 8; ++j) o[64 * j] = v[j] * rstd * gq[j];
}
__device__ __forceinline__ void unpack8(u32x4_t w, float (&f)[8]) { f[0] = __uint_as_float(w.x << 16); f[1] = __uint_as_float(w.x & 0xffff0000u); f[2] = __uint_as_float(w.y << 16); f[3] = __uint_as_float(w.y & 0xffff0000u);
    f[4] = __uint_as_float(w.z << 16); f[5] = __uint_as_float(w.z & 0xffff0000u); f[6] = __uint_as_float(w.w << 16); f[7] = __uint_as_float(w.w & 0xffff0000u); }
__device__ __forceinline__ u32x4_t pack8f(const float (&f)[8]) { u32x4_t w; w.x = pk2(f[0], f[1]); w.y = pk2(f[2], f[3]); w.z = pk2(f[4], f[5]); w.w = pk2(f[6], f[7]); return w; }
__device__ __forceinline__ void rope_load(int r, const bf16_t* __restrict__ P, int lane, u32x4_t (&xr)[4]) {
    const size_t prow = (size_t)(MCTX + r) * PROJW;
#pragma unroll
    for (int i = 0; i < 2; ++i) { const int task = lane + 64 * i, which = task >> 6, grp = (task >> 1) & 31, hj = task & 1, col = grp * 32 + 8 * hj;
        const bf16_t* src = P + prow + (which ? 3072 : 2048) + col; xr[2 * i] = *(const u32x4_t*)src; xr[2 * i + 1] = *(const u32x4_t*)(src + 16); }
}
__device__ __forceinline__ void rope_finish(int r, const u32x4_t (&xr)[4], bf16_t* __restrict__ QB, bf16_t* __restrict__ KB, const LAS float* tab, int lane) {
    const int b = r >> 12, t = r & 4095;
#pragma unroll
    for (int i = 0; i < 2; ++i) { const int task = lane + 64 * i, which = task >> 6, grp = (task >> 1) & 31, hj = task & 1, col = grp * 32 + 8 * hj;
        const int pos = (grp & 1) ? (t & 63) : (t >> 6);
        float x1[8], x2[8], o1[8], o2[8]; unpack8(xr[2 * i], x1); unpack8(xr[2 * i + 1], x2);
        const LAS float* tp = tab + (pos * 16 + 8 * hj) * 2;
#pragma unroll
        for (int e = 0; e < 8; ++e) { const float cs = tp[2 * e], sn = tp[2 * e + 1]; o1[e] = x1[e] * cs - x2[e] * sn; o2[e] = x1[e] * sn + x2[e] * cs; }
        bf16_t* dst = which ? KB + ((size_t)b * LK_LAT + PAST + t) * 1024 + col : QB + (size_t)r * 1024 + col;
        *(u32x4_t*)dst = pack8f(o1); *(u32x4_t*)(dst + 16) = pack8f(o2); }
}
__device__ __forceinline__ void pool_row(int row, const bf16_t* __restrict__ P, bf16_t* __restrict__ CAT, int lane) {
    int seq0, L, t; row_geom(row, seq0, L, t);
    const int w = 2 << (lane >> 4), a = w >> 1, bb = w - a - 1, lo = t - a < 0 ? 0 : t - a, hi = t + bb + 1 > L ? L : t + bb + 1;
    float s[8], x[8]; u32x4_t tap[16];
#pragma unroll
    for (int o = 0; o < 16; ++o) { const int tt = t + o - 8; tap[o] = *(const u32x4_t*)(P + (size_t)(seq0 + ((tt >= lo && tt < hi) ? tt : t)) * PROJW + 5120 + 8 * lane); }
#pragma unroll
    for (int e = 0; e < 8; ++e) s[e] = 0.f;
#pragma unroll
    for (int o = 0; o < 16; ++o) { const int tt = t + o - 8; const float wgt = (tt >= lo && tt < hi) ? 1.0f : 0.0f; float v[8]; unpack8(tap[o], v);
#pragma unroll
        for (int e = 0; e < 8; ++e) s[e] += v[e] * wgt; }
    unpack8(*(const u32x4_t*)(P + (size_t)row * PROJW + 5120 + 8 * lane), x);
    const float inv = 1.0f / (float)(hi - lo);
#pragma unroll
    for (int e = 0; e < 8; ++e) s[e] = s[e] * inv - x[e];
    *(u32x4_t*)(CAT + (size_t)row * D + 1536 + 8 * lane) = pack8f(s);
}
__device__ __forceinline__ void gdn_out_row(int row, const float* __restrict__ OF, const float* __restrict__ OB, const bf16_t* __restrict__ P, const float* __restrict__ gnorm, bf16_t* __restrict__ CAT, int lane) {
    const size_t o = (size_t)row * 512 + 8 * lane; const int c0 = 8 * (lane & 15);
    const f32x4_t f0 = *(const f32x4_t*)(OF + o), f1 = *(const f32x4_t*)(OF + o + 4), b0 = *(const f32x4_t*)(OB + o), b1 = *(const f32x4_t*)(OB + o + 4);
    const u32x4_t zr = *(const u32x4_t*)(P + (size_t)row * PROJW + 1536 + 8 * lane);
    const f32x4_t g0 = *(const f32x4_t*)(gnorm + c0), g1 = *(const f32x4_t*)(gnorm + c0 + 4);
    const f32x4_t x0 = f0 + b0, x1 = f1 + b1;
    float ss = ((x0.x * x0.x + x0.y * x0.y) + (x0.z * x0.z + x0.w * x0.w)) + ((x1.x * x1.x + x1.y * x1.y) + (x1.z * x1.z + x1.w * x1.w));
    ss += lane_get(ss, lane ^ 1); ss += lane_get(ss, lane ^ 2); ss += lane_get(ss, lane ^ 4); ss += lane_get(ss, lane ^ 8);
    const float r = rsqrtf(ss * (1.0f / 128.0f) + EPS);
    float z[8], y[8]; unpack8(zr, z);
    y[0] = x0.x * r * g0.x * silu(z[0]); y[1] = x0.y * r * g0.y * silu(z[1]); y[2] = x0.z * r * g0.z * silu(z[2]); y[3] = x0.w * r * g0.w * silu(z[3]);
    y[4] = x1.x * r * g1.x * silu(z[4]); y[5] = x1.y * r * g1.y * silu(z[5]); y[6] = x1.z * r * g1.z * silu(z[6]); y[7] = x1.w * r * g1.w * silu(z[7]);
    *(u32x4_t*)(CAT + (size_t)row * D + 8 * lane) = pack8f(y);
}
constexpr int GBLK_W = 0, GBLK_Q = 16384, GBLK_K = 32768, GBLK_A = 49152, GBLK_U = 57344, GBLK_GL = 90112, GBLK_BYTES = 92160, GBLK_DMA = 57344;
constexpr size_t WS_GBLK = 974 * MiB;
static_assert(WS_GBLK + (size_t)1536 * GBLK_BYTES <= 1152 * MiB, "gdn blocks");
typedef short bf16x8_t __attribute__((ext_vector_type(8)));
typedef __bf16 bf16x2v_t __attribute__((ext_vector_type(2)));
typedef float f32x2v_t __attribute__((ext_vector_type(2)));
__device__ __forceinline__ unsigned cvt2(float lo, float hi) { f32x2v_t v = {lo, hi}; bf16x2v_t b = __builtin_convertvector(v, bf16x2v_t); return __builtin_bit_cast(unsigned, b); }
__device__ __forceinline__ bf16x8_t pack8(f32x4_t a, f32x4_t b) { u32x4_t w; w.x = cvt2(a.x, a.y); w.y = cvt2(a.z, a.w); w.z = cvt2(b.x, b.y); w.w = cvt2(b.z, b.w); return __builtin_bit_cast(bf16x8_t, w); }
__device__ __forceinline__ int img_byte(int r, int c) { const int st = (r >> 4) * 2 + (c >> 5), rr = r & 15, cc = c & 31, ob = rr * 64 + cc * 2; return st * 1024 + (ob ^ (((ob >> 9) & 1) << 5)); }
__device__ __forceinline__ int posinv(int x) { const int g = x & ~31, y = x & 31; return g + 8 * ((y >> 2) & 3) + 4 * (y >> 4) + (y & 3); }
__device__ __forceinline__ int gdn_block_index(int b, int dir, int h, int n, bool lat) { return lat ? 512 + (((b * 2 + dir) * 4 + h) * 64 + n) : ((b * 2 + dir) * 4 + h) * 4 + n; }

__device__ __forceinline__ void gdn_prep_item(int item, const bf16_t* __restrict__ P, const float* __restrict__ AB, const float* __restrict__ conv, const float* __restrict__ a_log, const float* __restrict__ dt_bias,
                                              unsigned char* __restrict__ gblk, LAS unsigned char* lds, int tid) {
    asm volatile("" : "+v"(tid));
    int vz = 0; asm volatile("" : "+v"(vz));
    LAS float* kf = (LAS float*)lds + vz; LAS float* vf = kf + 64 * 132; LAS unsigned char* R2 = (LAS unsigned char*)(vf + 64 * 132); LAS float* R3 = (LAS float*)(R2 + 32768); LAS float* sm = R3 + 8192;
    int b, nb, h, seq0, NC; bool lat;
    if (item < 256) { lat = false; b = item >> 4; nb = (item >> 2) & 3; h = item & 3; seq0 = b * 256; NC = 4; }
    else { const int i2 = item - 256; lat = true; b = i2 >> 8; nb = (i2 >> 2) & 63; h = i2 & 3; seq0 = MCTX + b * 4096; NC = 64; }
    const int t0 = nb * 64, Lseq = NC * 64;
    unsigned char* blk0 = gblk + (size_t)gdn_block_index(b, 0, h, nb, lat) * GBLK_BYTES;
    unsigned char* blk1 = gblk + (size_t)gdn_block_index(b, 1, h, NC - 1 - nb, lat) * GBLK_BYTES;
    const int lane = tid & 63, wave = tid >> 6, fr = lane & 15, fq = lane >> 4;
    __syncthreads();
    u32x4_t xr[6][4];
#pragma unroll
    for (int i = 0; i < 6; ++i) { const int id = tid + 512 * i, c = id / 48, r48 = id - c * 48, part = r48 >> 4, ch8 = (r48 & 15) * 8, tok = t0 + c, col = part * 512 + h * 128 + ch8;
#pragma unroll
        for (int j = 0; j < 4; ++j) { const int tt = tok + j - 2; const bool ok = tt >= 0 && tt < Lseq; xr[i][j] = *(const u32x4_t*)(P + (size_t)(seq0 + (ok ? tt : tok)) * PROJW + col); } }
#pragma unroll
    for (int i = 0; i < 6; ++i) { const int id = tid + 512 * i, c = id / 48, r48 = id - c * 48, part = r48 >> 4, ch8 = (r48 & 15) * 8, tok = t0 + c, col = part * 512 + h * 128 + ch8;
        float acc[8];
#pragma unroll
        for (int e = 0; e < 8; ++e) acc[e] = 0.f;
#pragma unroll
        for (int j = 0; j < 4; ++j) { const int tt = tok + j - 2; const float vm = (tt >= 0 && tt < Lseq) ? 1.0f : 0.0f; float x[8]; unpack8(xr[i][j], x);
            const f32x4_t w0 = *(const f32x4_t*)(conv + j * 1536 + col) * vm, w1 = *(const f32x4_t*)(conv + j * 1536 + col + 4) * vm;
            acc[0] += x[0] * w0.x; acc[1] += x[1] * w0.y; acc[2] += x[2] * w0.z; acc[3] += x[3] * w0.w; acc[4] += x[4] * w1.x; acc[5] += x[5] * w1.y; acc[6] += x[6] * w1.z; acc[7] += x[7] * w1.w; }
        LAS float* dst = part == 0 ? R3 + c * 128 + ch8 : (part == 1 ? kf : vf) + c * 132 + ch8;
        *(LAS f32x4_t*)dst = (f32x4_t){silu(acc[0]), silu(acc[1]), silu(acc[2]), silu(acc[3])}; *(LAS f32x4_t*)(dst + 4) = (f32x4_t){silu(acc[4]), silu(acc[5]), silu(acc[6]), silu(acc[7])}; }
    if (wave < 2) {
        const int d = wave; const size_t row = (size_t)(seq0 + t0 + (d ? 63 - lane : lane));
        const float av = AB[row * 16 + d * 4 + h] + dt_bias[d * 4 + h], bv = AB[row * 16 + 8 + d * 4 + h];
        float g = -__expf(a_log[d * 4 + h]) * (fmaxf(av, 0.f) + __logf(1.0f + __expf(-fabsf(av)))); const float beta = 1.0f / (1.0f + __expf(-bv));
#pragma unroll
        for (int o = 1; o < 64; o <<= 1) { const float t = lane_get(g, (lane - o) & 63); if (lane >= o) g += t; }
        const float glast = lane_get(g, 63);
        LAS float* s = sm + d * 256; s[lane] = g; s[64 + lane] = beta; s[128 + lane] = __expf(g); s[192 + lane] = __expf(glast - g);
        if (lane == 0) *(float*)((d ? blk1 : blk0) + GBLK_GL) = __expf(glast);
    }
    __syncthreads();
    { const int c = tid >> 3, part = (tid >> 2) & 1, q4 = tid & 3; LAS float* rowp = part ? kf + c * 132 + 32 * q4 : R3 + c * 128 + 32 * q4; float ss = 0.f; f32x4_t v[8];
#pragma unroll
      for (int e = 0; e < 8; ++e) { v[e] = *(const LAS f32x4_t*)(rowp + 4 * e); ss += (v[e].x * v[e].x + v[e].y * v[e].y) + (v[e].z * v[e].z + v[e].w * v[e].w); }
      ss += lane_get(ss, lane ^ 1); ss += lane_get(ss, lane ^ 2);
      const float r = rsqrtf(ss + EPS) * (part ? 1.0f : 0.08838834764831845f);
      LAS unsigned char* img = R2 + (part ? 0 : 16384);
#pragma unroll
      for (int e = 0; e < 8; ++e) v[e] = v[e] * r;
      if (part) {
#pragma unroll
          for (int e = 0; e < 8; ++e) *(LAS f32x4_t*)(rowp + 4 * e) = v[e]; }
#pragma unroll
      for (int e2 = 0; e2 < 4; ++e2) { const int col = 32 * q4 + 8 * e2; u32x4_t w; w.x = pk2(v[2 * e2].x, v[2 * e2].y); w.y = pk2(v[2 * e2].z, v[2 * e2].w); w.z = pk2(v[2 * e2 + 1].x, v[2 * e2 + 1].y); w.w = pk2(v[2 * e2 + 1].z, v[2 * e2 + 1].w);
          *(LAS u32x4_t*)(img + img_byte(c + 64 * (col >> 6), col & 63)) = w; } }
    __syncthreads();
    f32x4_t kk[2], qk[2];
    { const int aoff = img_byte(fr, fq * 8), it = wave >> 1, jt0 = 2 * (wave & 1);
      kk[0] = kk[1] = qk[0] = qk[1] = (f32x4_t){0.f, 0.f, 0.f, 0.f};
#pragma unroll
      for (int ks = 0; ks < 4; ++ks) { const int ko = 4 * (ks >> 1) * 2048 + (ks & 1) * 1024;
          const bf16x8_t xk = *(const LAS bf16x8_t*)(R2 + aoff + it * 2048 + ko), xq = *(const LAS bf16x8_t*)(R2 + 16384 + aoff + it * 2048 + ko);
#pragma unroll
          for (int jj = 0; jj < 2; ++jj) { const bf16x8_t yk = *(const LAS bf16x8_t*)(R2 + aoff + (jt0 + jj) * 2048 + ko);
              kk[jj] = __builtin_amdgcn_mfma_f32_16x16x32_bf16(xk, yk, kk[jj], 0, 0, 0); qk[jj] = __builtin_amdgcn_mfma_f32_16x16x32_bf16(xq, yk, qk[jj], 0, 0, 0); } } }
#pragma unroll
    for (int i = 0; i < 4; ++i) { const int id = tid + 512 * i, d = id >> 10, r = id & 1023, c = r >> 4, p8 = r & 15, ks = p8 >> 2, fq2 = p8 & 3, tc = d ? 63 - c : c; const float e = sm[d * 256 + 128 + c];
        const int dk0 = 32 * ks + 4 * fq2, dk1 = dk0 + 16;
        const unsigned long long a = *(const LAS unsigned long long*)(R2 + 16384 + img_byte(tc + 64 * (dk0 >> 6), dk0 & 63)), bq = *(const LAS unsigned long long*)(R2 + 16384 + img_byte(tc + 64 * (dk1 >> 6), dk1 & 63));
        u32x4_t w; w.x = pk2(__uint_as_float((unsigned)a << 16) * e, __uint_as_float((unsigned)a & 0xffff0000u) * e); w.y = pk2(__uint_as_float((unsigned)(a >> 32) << 16) * e, __uint_as_float((unsigned)(a >> 32) & 0xffff0000u) * e);
        w.z = pk2(__uint_as_float((unsigned)bq << 16) * e, __uint_as_float((unsigned)bq & 0xffff0000u) * e); w.w = pk2(__uint_as_float((unsigned)(bq >> 32) << 16) * e, __uint_as_float((unsigned)(bq >> 32) & 0xffff0000u) * e);
        const int pos = 8 * p8; *(u32x4_t*)((d ? blk1 : blk0) + GBLK_Q + img_byte(c + 64 * (pos >> 6), pos & 63)) = w; }
#pragma unroll
    for (int i = 0; i < 4; ++i) { const int id = tid + 512 * i, d = id >> 10, r = id & 1023, dk = r & 127, p8 = r >> 7, grp = p8 >> 2, fq2 = p8 & 3; float v[8];
#pragma unroll
        for (int e = 0; e < 8; ++e) { const int c = 32 * grp + 16 * (e >> 2) + 4 * fq2 + (e & 3), tc = d ? 63 - c : c; v[e] = kf[tc * 132 + dk] * sm[d * 256 + 192 + c]; }
        u32x4_t w; w.x = pk2(v[0], v[1]); w.y = pk2(v[2], v[3]); w.z = pk2(v[4], v[5]); w.w = pk2(v[6], v[7]);
        *(u32x4_t*)((d ? blk1 : blk0) + GBLK_K + img_byte(dk, 8 * p8)) = w; }
    __syncthreads();
    { const int it = wave >> 1, jt0 = 2 * (wave & 1); LAS float* KKs = (LAS float*)R2; LAS float* QKs = KKs + 4096;
#pragma unroll
      for (int jj = 0; jj < 2; ++jj)
#pragma unroll
          for (int e = 0; e < 4; ++e) { const int i = 16 * it + 4 * fq + e, j = 16 * (jt0 + jj) + fr; KKs[i * 64 + j] = kk[jj][e]; QKs[i * 64 + j] = qk[jj][e]; } }
    __syncthreads();
    { const LAS float* KKs = (const LAS float*)R2; const LAS float* QKs = KKs + 4096;
#pragma unroll
      for (int i = 0; i < 4; ++i) { const int id = tid + 512 * i, d = id >> 10, r = id & 1023, c = r >> 4, j0 = 4 * (r & 15), tc = d ? 63 - c : c; const LAS float* s = sm + d * 256; const float gcc = s[c], bc = s[64 + c];
          float lv[4], av[4];
#pragma unroll
          for (int e = 0; e < 4; ++e) { const int j = j0 + e, tj = d ? 63 - j : j; const float dec = __expf(fminf(gcc - s[j], 0.f));
              lv[e] = c > j ? bc * KKs[tc * 64 + tj] * dec : 0.f; av[e] = c >= j ? QKs[tc * 64 + tj] * dec : 0.f; }
          *(LAS f32x4_t*)(R3 + d * 4096 + c * 64 + j0) = (f32x4_t){lv[0], lv[1], lv[2], lv[3]};
          *(unsigned long long*)((d ? blk1 : blk0) + GBLK_A + img_byte(c, posinv(j0))) = (unsigned long long)pk2(av[0], av[1]) | ((unsigned long long)pk2(av[2], av[3]) << 32); } }
    __syncthreads();
    const int d = wave >> 2, w4 = wave & 3, colu = (w4 & 1) * 64 + lane; const LAS float* smd = sm + d * 256; const LAS float* Lm = R3 + d * 4096;
    float U[64];
#pragma unroll
    for (int c = 0; c < 64; ++c) { const int tc = d ? 63 - c : c; U[c] = w4 < 2 ? smd[64 + c] * vf[tc * 132 + colu] : smd[64 + c] * smd[128 + c] * kf[tc * 132 + colu]; }
    __syncthreads();
#pragma unroll
    for (int c = 1; c < 64; ++c) {
        f32x4_t l4[16];
#pragma unroll
        for (int j4 = 0; j4 < (c + 3) / 4; ++j4) l4[j4] = *(const LAS f32x4_t*)(Lm + c * 64 + 4 * j4);
        __builtin_amdgcn_sched_barrier(0);
        float acc = U[c], acc2 = 0.f;
#pragma unroll
        for (int j4 = 0; j4 < (c + 3) / 4; ++j4) {
            acc -= l4[j4].x * U[4 * j4]; if (4 * j4 + 1 < c) acc2 -= l4[j4].y * U[4 * j4 + 1]; if (4 * j4 + 2 < c) acc -= l4[j4].z * U[4 * j4 + 2]; if (4 * j4 + 3 < c) acc2 -= l4[j4].w * U[4 * j4 + 3]; }
        U[c] = acc + acc2;
        __builtin_amdgcn_sched_barrier(0); }
    unsigned char* blk = d ? blk1 : blk0;
    LAS unsigned short* wimg = (LAS unsigned short*)((LAS unsigned char*)vf + d * 16384);
    if (w4 < 2) {
        const int ds = colu >> 4, f16 = colu & 15; float* ub = (float*)(blk + GBLK_U);
#pragma unroll
        for (int c4 = 0; c4 < 16; ++c4) { const int ct = c4 >> 2, fq2 = c4 & 3; *(f32x4_t*)(ub + ((ds * 4 + ct) * 64 + fq2 * 16 + f16) * 4) = (f32x4_t){U[4 * c4], U[4 * c4 + 1], U[4 * c4 + 2], U[4 * c4 + 3]}; }
    } else {
        const int pos = posinv(colu), rofs = 64 * (pos >> 6), col = pos & 63;
#pragma unroll
        for (int c = 0; c < 64; ++c) wimg[img_byte(c + rofs, col) >> 1] = (unsigned short)f2bf(-U[c]);
    }
    __syncthreads();
#pragma unroll
    for (int i = 0; i < 4; ++i) { const int o = (tid + 512 * i) * 16, dd = o >> 14, oo = o & 16383; *(u32x4_t*)((dd ? blk1 : blk0) + GBLK_W + oo) = *(const LAS u32x4_t*)((LAS unsigned char*)vf + o); }
}

__device__ __forceinline__ void gdn_scan_chain(int chain, const unsigned char* __restrict__ gblk, float* __restrict__ OF, float* __restrict__ OB, const float* __restrict__ state_in, float* __restrict__ state_out,
                                               int layer, LAS unsigned char* lds, int tid) {
    const int lane = tid & 63, wave = __builtin_amdgcn_readfirstlane(tid >> 6), fr = lane & 15, fq = lane >> 4, dv = wave * 16 + fr;
    int b, dir, h, seq0, NC, blk0; bool lat;
    if (chain < 128) { lat = false; b = chain >> 3; dir = (chain >> 2) & 1; h = chain & 3; seq0 = b * 256; NC = 4; blk0 = chain * 4; }
    else { const int c2 = chain - 128; lat = true; b = c2 >> 3; dir = (c2 >> 2) & 1; h = c2 & 3; seq0 = MCTX + b * 4096; NC = 64; blk0 = 512 + c2 * 64; }
    const int L = NC * 64;
    f32x4_t S[8];
    const size_t sbase = ((((size_t)b * 2 + layer) * 2 + dir) * 4 + h) * 16384;
    if (lat) {
#pragma unroll
        for (int dt = 0; dt < 8; ++dt)
#pragma unroll
            for (int e = 0; e < 4; ++e) S[dt][e] = state_in[sbase + (size_t)(16 * dt + 4 * fq + e) * 128 + dv]; }
    else {
#pragma unroll
        for (int dt = 0; dt < 8; ++dt) S[dt] = (f32x4_t){0.f, 0.f, 0.f, 0.f}; }
    float* O = dir ? OB : OF;
    const int aoff = img_byte(fr, fq * 8);
    __syncthreads();
    { const unsigned char* src = gblk + (size_t)blk0 * GBLK_BYTES + wave * 1024 + lane * 16;
#pragma unroll
      for (int i = 0; i < 7; ++i) __builtin_amdgcn_global_load_lds((const unsigned*)(src + i * 8192), (LAS unsigned*)(lds + i * 8192 + wave * 1024), 16, 0, 0); }
    f32x4_t ucur[4], unext[4];
    { const float* ub = (const float*)(gblk + (size_t)blk0 * GBLK_BYTES + GBLK_U);
#pragma unroll
      for (int ct = 0; ct < 4; ++ct) ucur[ct] = *(const f32x4_t*)(ub + ((wave * 4 + ct) * 64 + lane) * 4); }
    for (int n = 0; n < NC; ++n) {
        asm volatile("s_waitcnt vmcnt(0)" ::: "memory");
        __builtin_amdgcn_s_barrier();
        asm volatile("" ::: "memory");
        const unsigned char* cblk = gblk + (size_t)(blk0 + n) * GBLK_BYTES;
        LAS unsigned char* buf = lds + (n & 1) * GBLK_DMA;
        if (n + 1 < NC) {
            const unsigned char* src = cblk + GBLK_BYTES + wave * 1024 + lane * 16; LAS unsigned char* nb = lds + ((n + 1) & 1) * GBLK_DMA;
#pragma unroll
            for (int i = 0; i < 7; ++i) __builtin_amdgcn_global_load_lds((const unsigned*)(src + i * 8192), (LAS unsigned*)(nb + i * 8192 + wave * 1024), 16, 0, 0);
            const float* ub = (const float*)(cblk + GBLK_BYTES + GBLK_U);
#pragma unroll
            for (int ct = 0; ct < 4; ++ct) unext[ct] = *(const f32x4_t*)(ub + ((wave * 4 + ct) * 64 + lane) * 4);
        }
        const float gl = *(const float*)(cblk + GBLK_GL);
        bf16x8_t Ys[4];
#pragma unroll
        for (int ks = 0; ks < 4; ++ks) Ys[ks] = pack8(S[2 * ks], S[2 * ks + 1]);
        f32x4_t av[4], ao[4];
#pragma unroll
        for (int ct = 0; ct < 4; ++ct) { av[ct] = ucur[ct]; ao[ct] = (f32x4_t){0.f, 0.f, 0.f, 0.f}; }
#pragma unroll
        for (int ct = 0; ct < 4; ++ct)
#pragma unroll
            for (int ks = 0; ks < 4; ++ks) { const int o = aoff + (ct + 4 * (ks >> 1)) * 2048 + (ks & 1) * 1024;
                const bf16x8_t xw = *(const LAS bf16x8_t*)(buf + GBLK_W + o), xq = *(const LAS bf16x8_t*)(buf + GBLK_Q + o);
                av[ct] = __builtin_amdgcn_mfma_f32_16x16x32_bf16(xw, Ys[ks], av[ct], 0, 0, 0);
                ao[ct] = __builtin_amdgcn_mfma_f32_16x16x32_bf16(xq, Ys[ks], ao[ct], 0, 0, 0); }
        bf16x8_t Yv[2];
#pragma unroll
        for (int ks = 0; ks < 2; ++ks) Yv[ks] = pack8(av[2 * ks], av[2 * ks + 1]);
#pragma unroll
        for (int ct = 0; ct < 4; ++ct)
#pragma unroll
            for (int ks = 0; ks < 2; ++ks) { const bf16x8_t xa = *(const LAS bf16x8_t*)(buf + GBLK_A + aoff + ct * 2048 + ks * 1024);
                ao[ct] = __builtin_amdgcn_mfma_f32_16x16x32_bf16(xa, Yv[ks], ao[ct], 0, 0, 0); }
#pragma unroll
        for (int dt = 0; dt < 8; ++dt) { S[dt] = S[dt] * gl;
#pragma unroll
            for (int ks = 0; ks < 2; ++ks) { const bf16x8_t xk = *(const LAS bf16x8_t*)(buf + GBLK_K + aoff + dt * 2048 + ks * 1024);
                S[dt] = __builtin_amdgcn_mfma_f32_16x16x32_bf16(xk, Yv[ks], S[dt], 0, 0, 0); } }
#pragma unroll
        for (int ct = 0; ct < 4; ++ct)
#pragma unroll
            for (int e = 0; e < 4; ++e) { const int s = n * 64 + 16 * ct + 4 * fq + e, t = dir ? L - 1 - s : s; O[(size_t)(seq0 + t) * 512 + h * 128 + dv] = ao[ct][e]; }
#pragma unroll
        for (int ct = 0; ct < 4; ++ct) ucur[ct] = unext[ct];
    }
    if (!lat) {
#pragma unroll
        for (int dt = 0; dt < 8; ++dt)
#pragma unroll
            for (int e = 0; e < 4; ++e) state_out[sbase + (size_t)(16 * dt + 4 * fq + e) * 128 + dv] = S[dt][e]; }
    asm volatile("s_waitcnt vmcnt(0)" ::: "memory");
    __syncthreads();
}
__device__ __forceinline__ float xrow_max(float x) {
    auto s = __builtin_amdgcn_permlane16_swap(__float_as_uint(x), __float_as_uint(x), false, false); x = fmaxf(__uint_as_float(s[0]), __uint_as_float(s[1]));
    auto t = __builtin_amdgcn_permlane32_swap(__float_as_uint(x), __float_as_uint(x), false, false); return fmaxf(__uint_as_float(t[0]), __uint_as_float(t[1])); }
__device__ __forceinline__ void attn_stage_rc(int bb, int& R, int& C) { const int st = bb / 1024, sb = bb % 1024, swz = sb ^ (((sb >> 9) & 1) << 5); R = (st >> 1) * 16 + swz / 64; C = (st & 1) * 32 + (swz % 64) / 2; }
#ifndef ATT_FIXTHR
#define ATT_FIXTHR 8.0f
#endif
__device__ __forceinline__ void attn_unit(const bf16_t* __restrict__ Q, int ldq, const bf16_t* __restrict__ K, int ldk, const bf16_t* __restrict__ VT, int ldv, int NJ,
                                          const float* __restrict__ lamp, const float* __restrict__ dnorm, bf16_t* __restrict__ CATrow0, LAS unsigned char* lds, int tid, float* __restrict__ part) {
    const int lane = tid & 63, wave = __builtin_amdgcn_readfirstlane(tid >> 6), fr = lane & 15, fq = lane >> 4, comp = wave >> 2, wq = wave & 3;
    const float SC = 0.18033688011112042f;
    const float FIXTHR = ATT_FIXTHR;
    unsigned voffK, voffV[2];
    { int R, C; attn_stage_rc(tid * 16, R, C); voffK = (unsigned)(R * ldk + C) * 2u; voffV[0] = (unsigned)(R * ldv + C) * 2u; attn_stage_rc(tid * 16 + 8192, R, C); voffV[1] = (unsigned)(R * ldv + C) * 2u; }
    const int aoff = img_byte(fr, fq * 8);
    bf16x8_t Qf[2]; u32x4_t qraw[2];
#pragma unroll
    for (int ks = 0; ks < 2; ++ks) qraw[ks] = *(const u32x4_t*)(Q + (size_t)(16 * wq + fr) * ldq + comp * 64 + 32 * ks + 8 * fq);
#define ATT_QCONV() _Pragma("unroll") for (int ks = 0; ks < 2; ++ks) { float qf8[8]; unpack8(qraw[ks], qf8);     \
        u32x4_t w; w.x = cvt2(qf8[0] * SC, qf8[1] * SC); w.y = cvt2(qf8[2] * SC, qf8[3] * SC); w.z = cvt2(qf8[4] * SC, qf8[5] * SC); w.w = cvt2(qf8[6] * SC, qf8[7] * SC); Qf[ks] = __builtin_bit_cast(bf16x8_t, w); }
    f32x4_t O[8];
#pragma unroll
    for (int dt = 0; dt < 8; ++dt) O[dt] = (f32x4_t){0.f, 0.f, 0.f, 0.f};
    float m; f32x4_t Lacc = (f32x4_t){0.f, 0.f, 0.f, 0.f};
    const bf16x8_t ones8_ = (bf16x8_t){0x3F80, 0x3F80, 0x3F80, 0x3F80, 0x3F80, 0x3F80, 0x3F80, 0x3F80};
    __syncthreads();
#define ATT_STAGE(jb, kslot, vslot) do { LAS unsigned char* kl_ = lds + (kslot) * 16384 + wave * 1024; LAS unsigned char* vl_ = lds + 49152 + (vslot) * 16384 + wave * 1024; \
        const char* kp_ = (const char*)K + (size_t)(jb) * 64 * ldk * 2; const char* vp_ = (const char*)VT + (size_t)(jb) * 128; \
        __builtin_amdgcn_global_load_lds((const unsigned*)(kp_ + voffK), (LAS unsigned*)kl_, 16, 0, 0); \
        __builtin_amdgcn_global_load_lds((const unsigned*)(kp_ + 128 + voffK), (LAS unsigned*)(kl_ + 8192), 16, 0, 0); \
        __builtin_amdgcn_global_load_lds((const unsigned*)(vp_ + voffV[0]), (LAS unsigned*)vl_, 16, 0, 0); \
        __builtin_amdgcn_global_load_lds((const unsigned*)(vp_ + voffV[1]), (LAS unsigned*)(vl_ + 8192), 16, 0, 0); } while (0)
    ATT_STAGE(0, 0, 0); ATT_STAGE(1, 1, 1); ATT_STAGE(2, 2, 2);
    __builtin_amdgcn_sched_barrier(0);
    ATT_QCONV();
#undef ATT_QCONV
    asm volatile("s_waitcnt vmcnt(8)" ::: "memory");
    __builtin_amdgcn_s_barrier();
    asm volatile("" ::: "memory");
    f32x4_t S[4], Sn[4];
    bf16x8_t Yp[2] = {(bf16x8_t){0, 0, 0, 0, 0, 0, 0, 0}, (bf16x8_t){0, 0, 0, 0, 0, 0, 0, 0}};
    { const LAS unsigned char* ks_ = lds + comp * 8192 + aoff;
#pragma unroll
      for (int kt = 0; kt < 4; ++kt) { S[kt] = (f32x4_t){0.f, 0.f, 0.f, 0.f};
#pragma unroll
          for (int ks = 0; ks < 2; ++ks) S[kt] = __builtin_amdgcn_mfma_f32_16x16x32_bf16(*(const LAS bf16x8_t*)(ks_ + kt * 2048 + ks * 1024), Qf[ks], S[kt], 0, 0, 0); }
      float mx0 = fmaxf(fmaxf(fmaxf(fmaxf(S[0].x, S[0].y), fmaxf(S[0].z, S[0].w)), fmaxf(fmaxf(S[1].x, S[1].y), fmaxf(S[1].z, S[1].w))), fmaxf(fmaxf(fmaxf(S[2].x, S[2].y), fmaxf(S[2].z, S[2].w)), fmaxf(fmaxf(S[3].x, S[3].y), fmaxf(S[3].z, S[3].w))));
      m = xrow_max(mx0);
#pragma unroll
      for (int kt = 0; kt < 4; ++kt) S[kt] = S[kt] - m; }
    int vm1 = 0  , vj = 0  , vp3 = 3  ;
    for (int j = 0; j < NJ; ++j) {
        if (j + 2 < NJ) asm volatile("s_waitcnt vmcnt(4)" ::: "memory"); else asm volatile("s_waitcnt vmcnt(0)" ::: "memory");
        __builtin_amdgcn_s_barrier();
        asm volatile("" ::: "memory");
        if (j + 3 < NJ) ATT_STAGE(j + 3, j % 3, vp3);
        __builtin_amdgcn_sched_barrier(0);
        bf16x8_t Yn[2]; float alpha = 1.0f, dfix = 0.f; bool anyfix = false;
        const f32x4_t negm4_ = (f32x4_t){-m, -m, -m, -m};
        const LAS unsigned char* ksl_ = lds + ((j + 1) % 3) * 16384 + comp * 8192 + aoff; const LAS unsigned char* vsl_ = lds + 49152 + vm1 * 16384 + aoff;
#define SB_ __builtin_amdgcn_sched_barrier(0)
        { float mx_; bf16x8_t fA_, fB_, fC_, fD_, fE_, fF_;
          fA_ = *(const LAS bf16x8_t*)(ksl_ + 0); fB_ = *(const LAS bf16x8_t*)(ksl_ + 2048); fC_ = *(const LAS bf16x8_t*)(ksl_ + 4096); fD_ = *(const LAS bf16x8_t*)(ksl_ + 6144); fE_ = *(const LAS bf16x8_t*)(ksl_ + 1024);
          fF_ = *(const LAS bf16x8_t*)(ksl_ + 3072); Sn[0] = __builtin_amdgcn_mfma_f32_16x16x32_bf16(fA_, Qf[0], negm4_, 0, 0, 0); SB_;
          fA_ = *(const LAS bf16x8_t*)(ksl_ + 5120); Sn[1] = __builtin_amdgcn_mfma_f32_16x16x32_bf16(fB_, Qf[0], negm4_, 0, 0, 0); mx_ = fmaxf(fmaxf(fmaxf(S[0].x, S[0].y), fmaxf(S[0].z, S[0].w)), fmaxf(fmaxf(S[1].x, S[1].y), fmaxf(S[1].z, S[1].w))); SB_;
          fB_ = *(const LAS bf16x8_t*)(ksl_ + 7168); Sn[2] = __builtin_amdgcn_mfma_f32_16x16x32_bf16(fC_, Qf[0], negm4_, 0, 0, 0); SB_;
          fC_ = *(const LAS bf16x8_t*)(vsl_ + 0); Sn[3] = __builtin_amdgcn_mfma_f32_16x16x32_bf16(fD_, Qf[0], negm4_, 0, 0, 0); mx_ = fmaxf(mx_, fmaxf(fmaxf(fmaxf(S[2].x, S[2].y), fmaxf(S[2].z, S[2].w)), fmaxf(fmaxf(S[3].x, S[3].y), fmaxf(S[3].z, S[3].w)))); SB_;
          fD_ = *(const LAS bf16x8_t*)(vsl_ + 2048); Sn[0] = __builtin_amdgcn_mfma_f32_16x16x32_bf16(fE_, Qf[1], Sn[0], 0, 0, 0); SB_;
          fE_ = *(const LAS bf16x8_t*)(vsl_ + 4096); Sn[1] = __builtin_amdgcn_mfma_f32_16x16x32_bf16(fF_, Qf[1], Sn[1], 0, 0, 0); mx_ = xrow_max(mx_); anyfix = __any(mx_ > FIXTHR); if (anyfix) { dfix = mx_ > FIXTHR ? mx_ : 0.f; m += dfix; alpha = __builtin_amdgcn_exp2f(-dfix); _Pragma("unroll") for (int kt = 0; kt < 4; ++kt) S[kt] = S[kt] - dfix; } SB_;
          fF_ = *(const LAS bf16x8_t*)(vsl_ + 6144); Sn[2] = __builtin_amdgcn_mfma_f32_16x16x32_bf16(fA_, Qf[1], Sn[2], 0, 0, 0); SB_;
          fA_ = *(const LAS bf16x8_t*)(vsl_ + 8192); Sn[3] = __builtin_amdgcn_mfma_f32_16x16x32_bf16(fB_, Qf[1], Sn[3], 0, 0, 0); SB_;
          fB_ = *(const LAS bf16x8_t*)(vsl_ + 10240); O[0] = __builtin_amdgcn_mfma_f32_16x16x32_bf16(fC_, Yp[0], O[0], 0, 0, 0); S[0].x = __builtin_amdgcn_exp2f(S[0].x); S[0].y = __builtin_amdgcn_exp2f(S[0].y); S[0].z = __builtin_amdgcn_exp2f(S[0].z); S[0].w = __builtin_amdgcn_exp2f(S[0].w); SB_;
          fC_ = *(const LAS bf16x8_t*)(vsl_ + 12288); O[1] = __builtin_amdgcn_mfma_f32_16x16x32_bf16(fD_, Yp[0], O[1], 0, 0, 0); SB_;
          fD_ = *(const LAS bf16x8_t*)(vsl_ + 14336); O[2] = __builtin_amdgcn_mfma_f32_16x16x32_bf16(fE_, Yp[0], O[2], 0, 0, 0); SB_;
          fE_ = *(const LAS bf16x8_t*)(vsl_ + 1024); O[3] = __builtin_amdgcn_mfma_f32_16x16x32_bf16(fF_, Yp[0], O[3], 0, 0, 0); S[1].x = __builtin_amdgcn_exp2f(S[1].x); S[1].y = __builtin_amdgcn_exp2f(S[1].y); S[1].z = __builtin_amdgcn_exp2f(S[1].z); S[1].w = __builtin_amdgcn_exp2f(S[1].w); SB_;
          fF_ = *(const LAS bf16x8_t*)(vsl_ + 3072); O[4] = __builtin_amdgcn_mfma_f32_16x16x32_bf16(fA_, Yp[0], O[4], 0, 0, 0); SB_;
          fA_ = *(const LAS bf16x8_t*)(vsl_ + 5120); O[5] = __builtin_amdgcn_mfma_f32_16x16x32_bf16(fB_, Yp[0], O[5], 0, 0, 0); SB_;
          fB_ = *(const LAS bf16x8_t*)(vsl_ + 7168); O[6] = __builtin_amdgcn_mfma_f32_16x16x32_bf16(fC_, Yp[0], O[6], 0, 0, 0); S[2].x = __builtin_amdgcn_exp2f(S[2].x); S[2].y = __builtin_amdgcn_exp2f(S[2].y); S[2].z = __builtin_amdgcn_exp2f(S[2].z); S[2].w = __builtin_amdgcn_exp2f(S[2].w); SB_;
          fC_ = *(const LAS bf16x8_t*)(vsl_ + 9216); O[7] = __builtin_amdgcn_mfma_f32_16x16x32_bf16(fD_, Yp[0], O[7], 0, 0, 0); SB_;
          Lacc = __builtin_amdgcn_mfma_f32_16x16x32_bf16(ones8_, Yp[0], Lacc, 0, 0, 0); SB_;
          fD_ = *(const LAS bf16x8_t*)(vsl_ + 11264); O[0] = __builtin_amdgcn_mfma_f32_16x16x32_bf16(fE_, Yp[1], O[0], 0, 0, 0); S[3].x = __builtin_amdgcn_exp2f(S[3].x); S[3].y = __builtin_amdgcn_exp2f(S[3].y); S[3].z = __builtin_amdgcn_exp2f(S[3].z); S[3].w = __builtin_amdgcn_exp2f(S[3].w); SB_;
          fE_ = *(const LAS bf16x8_t*)(vsl_ + 13312); O[1] = __builtin_amdgcn_mfma_f32_16x16x32_bf16(fF_, Yp[1], O[1], 0, 0, 0); SB_;
          fF_ = *(const LAS bf16x8_t*)(vsl_ + 15360); O[2] = __builtin_amdgcn_mfma_f32_16x16x32_bf16(fA_, Yp[1], O[2], 0, 0, 0); SB_;
          O[3] = __builtin_amdgcn_mfma_f32_16x16x32_bf16(fB_, Yp[1], O[3], 0, 0, 0); Yn[0] = pack8(S[0], S[1]); Yn[1] = pack8(S[2], S[3]); SB_;
          O[4] = __builtin_amdgcn_mfma_f32_16x16x32_bf16(fC_, Yp[1], O[4], 0, 0, 0); SB_;
          O[5] = __builtin_amdgcn_mfma_f32_16x16x32_bf16(fD_, Yp[1], O[5], 0, 0, 0); SB_;
          O[6] = __builtin_amdgcn_mfma_f32_16x16x32_bf16(fE_, Yp[1], O[6], 0, 0, 0); SB_;
          O[7] = __builtin_amdgcn_mfma_f32_16x16x32_bf16(fF_, Yp[1], O[7], 0, 0, 0); SB_;
          Lacc = __builtin_amdgcn_mfma_f32_16x16x32_bf16(ones8_, Yp[1], Lacc, 0, 0, 0); SB_;
        }
        asm volatile("" : "+v"(Yn[0]), "+v"(Yn[1]));
#undef SB_
        __builtin_amdgcn_sched_barrier(0);
        if (anyfix) {
#pragma unroll
            for (int dt = 0; dt < 8; ++dt) O[dt] = O[dt] * alpha;
            Lacc = Lacc * alpha;
#pragma unroll
            for (int kt = 0; kt < 4; ++kt) Sn[kt] = Sn[kt] - dfix; }
#pragma unroll
        for (int kt = 0; kt < 4; ++kt) S[kt] = Sn[kt];
        Yp[0] = Yn[0]; Yp[1] = Yn[1];
        vm1 = vj; vj = vj == 4 ? 0 : vj + 1; vp3 = vp3 == 4 ? 0 : vp3 + 1;
    }
    { const LAS unsigned char* vs_ = lds + 49152 + vm1 * 16384 + aoff;
#pragma unroll
      for (int jj = 0; jj < 2; ++jj)
#pragma unroll
          for (int dt = 0; dt < 8; ++dt) O[dt] = __builtin_amdgcn_mfma_f32_16x16x32_bf16(*(const LAS bf16x8_t*)(vs_ + dt * 2048 + jj * 1024), Yp[jj], O[dt], 0, 0, 0);
      Lacc = __builtin_amdgcn_mfma_f32_16x16x32_bf16(ones8_, Yp[0], Lacc, 0, 0, 0); Lacc = __builtin_amdgcn_mfma_f32_16x16x32_bf16(ones8_, Yp[1], Lacc, 0, 0, 0); }
#undef ATT_STAGE
    if (part) {
        float* po = part + (size_t)(comp * 64 + 16 * wq + fr) * 128 + 4 * fq;
#pragma unroll
        for (int dt = 0; dt < 8; ++dt) *(f32x4_t*)(po + 16 * dt) = O[dt];
        if (fq == 0) { part[16384 + comp * 64 + 16 * wq + fr] = m; part[16384 + 128 + comp * 64 + 16 * wq + fr] = Lacc.x; }
        return;
    }
    const float lam = lamp[0], lam_init = lamp[1];
    { const float f = (comp ? lam : 1.0f) / Lacc.x;
#pragma unroll
      for (int dt = 0; dt < 8; ++dt) O[dt] = O[dt] * f; }
    __syncthreads();
    LAS float* ex = (LAS float*)lds;
    if (comp == 1) {
#pragma unroll
        for (int dt = 0; dt < 8; ++dt) *(LAS f32x4_t*)(ex + (16 * wq + fr) * 132 + 16 * dt + 4 * fq) = O[dt]; }
    __syncthreads();
    if (comp == 0) { float ss = 0.f;
#pragma unroll
        for (int dt = 0; dt < 8; ++dt) { O[dt] = O[dt] - *(const LAS f32x4_t*)(ex + (16 * wq + fr) * 132 + 16 * dt + 4 * fq);
            ss += (O[dt].x * O[dt].x + O[dt].y * O[dt].y) + (O[dt].z * O[dt].z + O[dt].w * O[dt].w); }
        ss += lane_get(ss, lane ^ 16); ss += lane_get(ss, lane ^ 32);
        const float r = rsqrtf(ss * (1.0f / 128.0f) + EPS) * (1.0f - lam_init);
        bf16_t* orow = CATrow0 + (size_t)(16 * wq + fr) * D;
#pragma unroll
        for (int dt = 0; dt < 8; ++dt) { const f32x4_t g = *(const f32x4_t*)(dnorm + 16 * dt + 4 * fq); const f32x4_t y = O[dt] * r * g;
            *(unsigned long long*)(orow + 16 * dt + 4 * fq) = (unsigned long long)pk2(y.x, y.y) | ((unsigned long long)pk2(y.z, y.w) << 32); }
    }
}
constexpr int PART_STRIDE = 16384 + 256;
__device__ __forceinline__ void attn_merge_row(int row, const float* __restrict__ part, const float* __restrict__ lamp, const float* __restrict__ dnorm, bf16_t* __restrict__ CAT, int lane) {
    const int u = row >> 6, r = row & 63; const float* pa = part + (size_t)(2 * u) * PART_STRIDE; const float* pb = pa + PART_STRIDE;
    float o[2][2];
#pragma unroll
    for (int c = 0; c < 2; ++c) { const float ma = pa[16384 + c * 64 + r], mb = pb[16384 + c * 64 + r], la = pa[16384 + 128 + c * 64 + r], lb = pb[16384 + 128 + c * 64 + r];
        const float mm = fmaxf(ma, mb), wa = __builtin_amdgcn_exp2f(ma - mm), wb = __builtin_amdgcn_exp2f(mb - mm), inv = 1.0f / (la * wa + lb * wb);
#pragma unroll
        for (int q = 0; q < 2; ++q) o[c][q] = (pa[(size_t)(c * 64 + r) * 128 + lane + 64 * q] * wa + pb[(size_t)(c * 64 + r) * 128 + lane + 64 * q] * wb) * inv; }
    const float lam = lamp[0], lam_init = lamp[1];
    const float x0 = o[0][0] - lam * o[1][0], x1 = o[0][1] - lam * o[1][1];
    const float rr = rsqrtf(wave_sum(x0 * x0 + x1 * x1, lane) * (1.0f / 128.0f) + EPS) * (1.0f - lam_init);
    bf16_t* orow = CAT + (size_t)(MCTX + 4096 + row) * D + 512 + 7 * 128;
    orow[lane] = (bf16_t)f2bf(x0 * rr * dnorm[lane]); orow[64 + lane] = (bf16_t)f2bf(x1 * rr * dnorm[64 + lane]);
}
__device__ __forceinline__ void vt_item_bf16(const bf16_t* __restrict__ Vsrc, int ldsrc, bf16_t* __restrict__ VTdst, int ldv, int lane) {
    u32x4_t v[16];
#pragma unroll
    for (int i = 0; i < 16; ++i) v[i] = *(const u32x4_t*)(Vsrc + (size_t)lane * ldsrc + 8 * i);
    const int pos = posinv(lane);
#pragma unroll
    for (int i = 0; i < 16; ++i) { const unsigned w[4] = {v[i].x, v[i].y, v[i].z, v[i].w};
#pragma unroll
        for (int j = 0; j < 4; ++j) { VTdst[(size_t)(8 * i + 2 * j) * ldv + pos] = (bf16_t)(w[j] & 0xffffu); VTdst[(size_t)(8 * i + 2 * j + 1) * ldv + pos] = (bf16_t)(w[j] >> 16); } }
}
__device__ __forceinline__ void vt_item_f32(const float* __restrict__ Vsrc, int ldsrc, bf16_t* __restrict__ VTdst, int ldv, int lane) {
    const int pos = posinv(lane);
#pragma unroll
    for (int hb = 0; hb < 2; ++hb) { f32x4_t v[16];
#pragma unroll
        for (int i = 0; i < 16; ++i) v[i] = *(const f32x4_t*)(Vsrc + (size_t)lane * ldsrc + 4 * (16 * hb + i));
#pragma unroll
        for (int i = 0; i < 16; ++i) { const int c = 4 * (16 * hb + i);
            VTdst[(size_t)c * ldv + pos] = (bf16_t)f2bf(v[i].x); VTdst[(size_t)(c + 1) * ldv + pos] = (bf16_t)f2bf(v[i].y); VTdst[(size_t)(c + 2) * ldv + pos] = (bf16_t)f2bf(v[i].z); VTdst[(size_t)(c + 3) * ldv + pos] = (bf16_t)f2bf(v[i].w); } }
}
typedef const __attribute__((address_space(4))) Args* KArgs;
__device__ __forceinline__ KArgs fresh_args() { KArgs k = (KArgs)__builtin_amdgcn_kernarg_segment_ptr(); asm volatile("" : "+s"(k)); return k; }
__device__ __forceinline__ void tail_convert(KArgs ka, LAS unsigned char* lds, int lo, int hi, int idx, int stride, int wave, int lane) {
    LAS float* scr = (LAS float*)(lds + wave * 8448); unsigned char* const W1 = ka->ws + WS_W + W_LAYER;
    for (int d = lo + idx; d < hi; d += stride) {
        const float* src; int ld, Kdst, mode, nblk, r; size_t wofs;
        if (d < DM1) { r = d; src = ka->in[10] + (size_t)D * NFF; ld = NFF; wofs = W_1IN; Kdst = D; mode = 1; nblk = NFF / 32; }
        else if (d < DM2) { r = d - DM1; src = ka->in[11] + (size_t)DFF * D; ld = D; wofs = W_1OUT; Kdst = DFF; mode = 0; nblk = D / 32; }
        else if (d < DM3) { r = d - DM2; src = ka->in[13] + (size_t)D * IN_COLS; ld = IN_COLS; wofs = W_IN; Kdst = D; mode = 2; nblk = NPROJ / 32; }
        else if (d < DM4) { r = d - DM3; src = ka->in[24] + (size_t)D * NFF; ld = NFF; wofs = W_2IN; Kdst = D; mode = 1; nblk = NFF / 32; }
        else if (d < DM5) { r = d - DM4; src = ka->in[22] + (size_t)D * D; ld = D; wofs = W_OUT; Kdst = D; mode = 0; nblk = D / 32; }
        else { r = d - DM5; src = ka->in[25] + (size_t)DFF * D; ld = D; wofs = W_2OUT; Kdst = DFF; mode = 0; nblk = D / 32; }
        tr_item(src, ld, (bf16_t*)(W1 + wofs), Kdst, mode, r, nblk, scr, lane, nullptr, nullptr); }
}
#define PHASE_IDS FRESH_LDS; const int tid = fresh_tid_w(wave_s), lane = tid & 63, wave = __builtin_amdgcn_readfirstlane(tid >> 6), gw = wg * NWAVES + wave; (void)lane; (void)gw; (void)lds
#define PHASE_PTRS KArgs ka = fresh_args(); unsigned char* const ws = ka->ws; float* const out = ka->out; (void)out; \
    float* const ADA = (float*)(ws + WS_ADA); float* const LAM = (float*)(ws + WS_LAM); float* const X = (float*)(ws + WS_X); bf16_t* const H = (bf16_t*)(ws + WS_H); bf16_t* const CAT = (bf16_t*)(ws + WS_CAT); \
    bf16_t* const ACT = (bf16_t*)(ws + WS_ACT); bf16_t* const P = (bf16_t*)(ws + WS_PROJ); float* const AB = (float*)(ws + WS_AB); float* const GQ = (float*)(ws + WS_GQ); float* const GK = (float*)(ws + WS_GK); \
    float* const GV = (float*)(ws + WS_GV); float* const GG = (float*)(ws + WS_GG); float* const GB = (float*)(ws + WS_GB); float* const OF = (float*)(ws + WS_OF); float* const OB = (float*)(ws + WS_OB); \
    bf16_t* const QB = (bf16_t*)(ws + WS_QB); bf16_t* const KB = (bf16_t*)(ws + WS_KB); bf16_t* const VTL = (bf16_t*)(ws + WS_VTL); bf16_t* const VTC = (bf16_t*)(ws + WS_VTC); \
    const unsigned char* const Wl = ws + WS_W + (size_t)l * W_LAYER; const float* const ada = ADA + (size_t)l * 3 * ADA_N; \
    (void)LAM; (void)X; (void)H; (void)CAT; (void)ACT; (void)P; (void)AB; (void)GQ; (void)GK; (void)GV; (void)GG; (void)GB; (void)OF; (void)OB; (void)QB; (void)KB; (void)VTL; (void)VTC; (void)Wl; (void)ada
__global__ void __launch_bounds__(NWAVES * 64, 2) mega_fwd(Args a) {
    extern __shared__ __attribute__((aligned(16))) unsigned char lds_raw[];
    LAS unsigned char* const lds0 = (LAS unsigned char*)lds_raw;
#define FRESH_LDS LAS unsigned char* lds = lds0; asm volatile("" : "+s"(lds))
    const int G = gridDim.x, wg = blockIdx.x, NGW = G * NWAVES, wave_s = __builtin_amdgcn_readfirstlane(threadIdx.x >> 6);
    if (threadIdx.x < 64) ((LAS unsigned*)(lds0 + LDS_MISC))[threadIdx.x] = 0u;
    __syncthreads();
    (void)xcd_barrier_post((unsigned*)(a.ws + WS_CTL) + CW_BAR, (volatile LAS unsigned*)(lds0 + LDS_MISC + 32));
#define GRID_BARRIER() do { FRESH_LDS; KArgs kb_ = fresh_args(); XcdBarrier b_; b_.bar = (unsigned*)(kb_->ws + WS_CTL) + CW_BAR; b_.x = xb_xcc_id(); b_.st = (volatile LAS unsigned*)(lds + LDS_MISC + 32); xcd_barrier(b_, fresh_tid_w(wave_s)); } while (0)

    { PHASE_IDS; KArgs ka = fresh_args(); Ptrs p;
      p.x_prompt = ka->in[0]; p.x_sample = ka->in[1]; p.c = ka->in[2]; p.cache_k = ka->in[3]; p.cache_v = ka->in[4]; p.state_gdn = ka->in[5]; p.c_ctx = ka->in[6]; p.w_ada = ka->in[7]; p.b_ada = ka->in[8];
      p.norm_ffn1 = ka->in[9]; p.ffn1_in = ka->in[10]; p.ffn1_out = ka->in[11]; p.norm_mix = ka->in[12]; p.w_in = ka->in[13]; p.gdn_conv = ka->in[14]; p.gdn_a_log = ka->in[15]; p.gdn_dt_bias = ka->in[16];
      p.gdn_norm = ka->in[17]; p.diff_lam = ka->in[18]; p.diff_norm = ka->in[19]; p.pool_w = ka->in[20]; p.pool_scale = ka->in[21]; p.w_out = ka->in[22]; p.norm_ffn2 = ka->in[23]; p.ffn2_in = ka->in[24];
      p.ffn2_out = ka->in[25]; p.final_norm = ka->in[26];
      ph_prologue(p, ka->ws, lds, gw, NGW, wave, lane, tid); }
    GRID_BARRIER();

    for (int l = 0; l < DEPTH; ++l) {
        { PHASE_IDS; PHASE_PTRS; const float* x_prompt = ka->in[0]; const float* x_sample = ka->in[1]; const float* gain = ka->in[9] + l * D;
          for (int row = gw; row < M; row += NGW) {
            const float* xrow = (l == 0) ? (row < MCTX ? x_prompt + (size_t)row * D : x_sample + (size_t)(row - MCTX) * D) : X + (size_t)row * D;
            norm_row(xrow, row, gain, ada + 0 * D, ada + 1 * D, H, nullptr, lane);
        } }
        GRID_BARRIER();
        { FRESH_LDS; PHASE_PTRS; pg8::Gemm g{H, (const bf16_t*)(Wl + W_1IN), M, NFF, D, 0}; pg8::StaticOrder S; S.init(M, NFF, G, wg); pg8::EpiSwiglu E{ACT, DFF, 0};
          pg8::gemm_phase<pg8::EpiSwiglu, pg8::StaticOrder, true, true>(lds, g, S, E, fresh_tid_w(wave_s)); }
        if (G == 256 && wg >= 128) { __syncthreads(); PHASE_IDS; KArgs ka = fresh_args(); tail_convert(ka, lds, l ? DSEG3 : DSEG0, l ? DSEG4 : DSEG1, (wg - 128) * NWAVES + wave, 128 * NWAVES, wave, lane); }
        GRID_BARRIER();
        { FRESH_LDS; PHASE_PTRS; pg8::Gemm g{ACT, (const bf16_t*)(Wl + W_1OUT), M, D, DFF, 0}; pg8::StaticOrder S; S.init(M, D, G, wg, 192); const float* r0_ = l == 0 ? ka->in[0] : X; const float* r1_ = l == 0 ? ka->in[1] : X + (size_t)4096 * D; pg8::EpiResidTQ E{X, r0_, r1_, ada + 2 * D, D, ADA_N, 0.5f, 0};
          pg8::gemm_phase<pg8::EpiResidTQ, pg8::StaticOrder, true, true, true>(lds, g, S, E, fresh_tid_w(wave_s)); }
        GRID_BARRIER();
        { PHASE_IDS; PHASE_PTRS; const float* gain = ka->in[12] + l * D;
          for (int row = gw; row < M; row += NGW) norm_row(X + (size_t)row * D, row, gain, ada + 3 * D, ada + 4 * D, H, nullptr, lane); }
        GRID_BARRIER();
        { FRESH_LDS; PHASE_PTRS; pg8::Gemm g{H, (const bf16_t*)(Wl + W_IN), M, NPROJ, D, 0}; pg8::StaticOrder S; S.init(M, NPROJ, G, wg);
          pg8::EpiProj E{P, AB, out + OUT_CK + (size_t)l * 256 * 1024, out + OUT_CV + (size_t)l * 256 * 1024};
          pg8::gemm_phase<pg8::EpiProj, pg8::StaticOrder, true, true>(lds, g, S, E, fresh_tid_w(wave_s)); }
        if (G == 256 && wg >= 160) { __syncthreads(); PHASE_IDS; KArgs ka = fresh_args(); tail_convert(ka, lds, l ? DSEG4 : DSEG1, l ? DSEG5 : DSEG2, (wg - 160) * NWAVES + wave, 96 * NWAVES, wave, lane); }
        GRID_BARRIER();
        { PHASE_IDS; PHASE_PTRS; const float* cache_k = ka->in[3]; const float* cache_v = ka->in[4]; const float* conv = ka->in[14] + (size_t)l * 4 * 1536; const float* a_log = ka->in[15] + l * 8; const float* dt_bias = ka->in[16] + l * 8;
          for (int item = wg; item < 768; item += G) gdn_prep_item(item, P, AB, conv, a_log, dt_bias, ws + WS_GBLK, lds, tid);
          __syncthreads();
          LAS float* tab = (LAS float*)lds;
          for (int i = tid; i < 1024; i += NWAVES * 64) { float sn, cs; sincosf((float)(i >> 4) * __expf(-(float)(i & 15) * 0.5756462732485114f), &sn, &cs); tab[2 * i] = cs; tab[2 * i + 1] = sn; }
          __syncthreads();
          for (int row = gw; row < M + 2 * PAST + 1664; row += NGW) {
            if (row < M) {
                u32x4_t xr[4];
                if (row >= MCTX) rope_load(row - MCTX, P, lane, xr);
                pool_row(row, P, CAT, lane);
                if (row >= MCTX) rope_finish(row - MCTX, xr, QB, KB, tab, lane);
            } else if (row < M + 2 * PAST) {
                const int r = row - M, b = r >> 9, kk = r & 511; const size_t sidx = (((size_t)b * DEPTH + l) * PAST + kk) * 1024, d = ((size_t)b * LK_LAT + kk) * 1024;
#pragma unroll
                for (int i = 0; i < 2; ++i) { const f32x4_t v0 = *(const f32x4_t*)(cache_k + sidx + 8 * (lane + 64 * i)), v1 = *(const f32x4_t*)(cache_k + sidx + 8 * (lane + 64 * i) + 4);
                    u32x4_t w; w.x = pk2(v0.x, v0.y); w.y = pk2(v0.z, v0.w); w.z = pk2(v1.x, v1.y); w.w = pk2(v1.z, v1.w); *(u32x4_t*)(KB + d + 8 * (lane + 64 * i)) = w; }
            } else {
                const int it = row - (M + 2 * PAST);
                if (it < 1152) { const int b = it / 576, r2 = it - b * 576, h = r2 / 72, kblk = r2 - h * 72; bf16_t* dst = VTL + ((size_t)(b * 8 + h) * 128) * LK_LAT + 64 * kblk;
                    if (kblk < 8) vt_item_f32(cache_v + (((size_t)b * DEPTH + l) * PAST + 64 * kblk) * 1024 + h * 128, 1024, dst, LK_LAT, lane);
                    else vt_item_bf16(P + (size_t)(MCTX + b * 4096 + 64 * (kblk - 8)) * PROJW + 4096 + h * 128, PROJW, dst, LK_LAT, lane); }
                else { const int i2 = it - 1152, b = i2 >> 5, h = (i2 >> 2) & 7, kblk = i2 & 3;
                    vt_item_bf16(P + (size_t)(b * 256 + 64 * kblk) * PROJW + 4096 + h * 128, PROJW, VTC + ((size_t)(b * 8 + h) * 128) * 256 + 64 * kblk, 256, lane); }
            }
          } }
        GRID_BARRIER();
        { PHASE_IDS; PHASE_PTRS; const float* state_gdn = ka->in[5];
          for (int ci = wg; ci < 144; ci += G) gdn_scan_chain(ci < 16 ? 128 + ci : ci - 16, ws + WS_GBLK, OF, OB, state_gdn, out + OUT_ST, l, lds, tid); }
        { PHASE_IDS; PHASE_PTRS; const float* dnorm = ka->in[19] + l * 128; unsigned* qhead = (unsigned*)(ws + WS_CTL) + CW_QUEUE + 64 * l; LAS unsigned* qslot = (LAS unsigned*)(lds + LDS_MISC + 64);
          bool lat_open = wg >= 16 || G < 32;
          for (;;) {
            __syncthreads();
            if (tid == 0) { unsigned it = 0xffffffffu; if (lat_open) { it = atomicAdd(qhead, 1u); if (it >= 1088u) it = 0xffffffffu; } if (it == 0xffffffffu) { it = atomicAdd(qhead + 128, 1u); it = it < 512u ? it + 1088u : 0xffffffffu; } *qslot = it; }
            __syncthreads();
            const unsigned item = *qslot;
            if (item >= 1600u) break;
            if (item >= 1088u) lat_open = false;
            const bf16_t *aQ, *aK, *aV; int ldq, ldk, ldv, nb, qrow0, hh; float* part = nullptr;
            if (item < 1088u) { const unsigned fu = item < 960u ? item : 960u + ((item - 960u) >> 1); const int kh = item < 960u ? -1 : (int)((item - 960u) & 1u);
                const int b = fu >> 9, h = (fu >> 6) & 7, qb = fu & 63; qrow0 = MCTX + b * 4096 + 64 * qb; hh = h;
                aQ = QB + (size_t)(b * 4096 + 64 * qb) * 1024 + h * 128; ldq = 1024; aK = KB + (size_t)b * LK_LAT * 1024 + h * 128; ldk = 1024; aV = VTL + ((size_t)(b * 8 + h) * 128) * LK_LAT; ldv = LK_LAT; nb = LK_LAT / 64;
                if (kh >= 0) { nb = LK_LAT / 128; aK += (size_t)kh * (LK_LAT / 2) * 1024; aV += (size_t)kh * (LK_LAT / 2); part = (float*)(ws + WS_ACT) + (size_t)((fu - 960u) * 2u + (unsigned)kh) * PART_STRIDE; } }
            else { const int i2 = item - 1088, b = i2 >> 5, h = (i2 >> 2) & 7, qb = i2 & 3; qrow0 = b * 256 + 64 * qb; hh = h;
                aQ = P + (size_t)qrow0 * PROJW + 2048 + h * 128; ldq = PROJW; aK = P + (size_t)(b * 256) * PROJW + 3072 + h * 128; ldk = PROJW; aV = VTC + ((size_t)(b * 8 + h) * 128) * 256; ldv = 256; nb = 4; }
            attn_unit(aQ, ldq, aK, ldk, aV, ldv, nb, LAM + 2 * l, dnorm, CAT + (size_t)qrow0 * D + 512 + hh * 128, lds, tid, part);
        } }
        GRID_BARRIER();
        { PHASE_IDS; PHASE_PTRS; const float* gnorm = ka->in[17] + l * 128;
          for (int row = gw; row < M; row += NGW) gdn_out_row(row, OF, OB, P, gnorm, CAT, lane);
          for (int row = gw; row < 4096; row += NGW) attn_merge_row(row, (const float*)(ws + WS_ACT), LAM + 2 * l, ka->in[19] + l * 128, CAT, lane); }
        GRID_BARRIER();
        { FRESH_LDS; PHASE_PTRS; pg8::Gemm g{CAT, (const bf16_t*)(Wl + W_OUT), M, D, D, 0}; pg8::StaticOrder S; S.init(M, D, G, wg, 192); pg8::EpiResidTQ E{X, X, X + (size_t)4096 * D, ada + 5 * D, D, ADA_N, 1.0f, 0};
          pg8::gemm_phase<pg8::EpiResidTQ, pg8::StaticOrder, true, true, true>(lds, g, S, E, fresh_tid_w(wave_s)); }
        GRID_BARRIER();
        { PHASE_IDS; PHASE_PTRS; const float* gain = ka->in[23] + l * D;
          for (int row = gw; row < M; row += NGW) norm_row(X + (size_t)row * D, row, gain, ada + 6 * D, ada + 7 * D, H, nullptr, lane); }
        GRID_BARRIER();
        { FRESH_LDS; PHASE_PTRS; pg8::Gemm g{H, (const bf16_t*)(Wl + W_2IN), M, NFF, D, 0}; pg8::StaticOrder S; S.init(M, NFF, G, wg); pg8::EpiSwiglu E{ACT, DFF, 0};
          pg8::gemm_phase<pg8::EpiSwiglu, pg8::StaticOrder, true, true>(lds, g, S, E, fresh_tid_w(wave_s)); }
        if (G == 256 && wg >= 128) { __syncthreads(); PHASE_IDS; KArgs ka = fresh_args(); tail_convert(ka, lds, l ? DSEG5 : DSEG2, l ? DSEG6 : DSEG3, (wg - 128) * NWAVES + wave, 128 * NWAVES, wave, lane); }
        GRID_BARRIER();
        { FRESH_LDS; PHASE_PTRS; pg8::Gemm g{ACT, (const bf16_t*)(Wl + W_2OUT), M, D, DFF, 0}; pg8::StaticOrder S; S.init(M, D, G, wg, 192); pg8::EpiResidTQ E{X, X, X + (size_t)4096 * D, ada + 8 * D, D, ADA_N, 0.5f, 0};
          pg8::gemm_phase<pg8::EpiResidTQ, pg8::StaticOrder, true, true, true>(lds, g, S, E, fresh_tid_w(wave_s)); }
        GRID_BARRIER();
    }
    { const int l = 0; PHASE_IDS; PHASE_PTRS; const float* gain = ka->in[26];
      for (int row = gw; row < M; row += NGW) final_norm_row(X, row, gain, out, lane); }
}

extern "C" void kernel_launch(void* const* d_in, const int* in_sizes, int n_in, void* d_out, int out_size, void* d_ws, size_t ws_size, hipStream_t stream) {
    static int grid = 0;
    if (grid == 0) {
        if (n_in != 27 || out_size != (int)OUT_TOTAL || ws_size < WS_END) { fprintf(stderr, "kernel_launch: unexpected sizes n_in %d out %d ws %zu\n", n_in, out_size, ws_size); grid = -1; return; }
        int dev = 0, cus = 0, per_cu = 0; (void)hipGetDevice(&dev); (void)hipDeviceGetAttribute(&cus, hipDeviceAttributeMultiprocessorCount, dev);
        if (hipFuncSetAttribute((const void*)mega_fwd, hipFuncAttributeMaxDynamicSharedMemorySize, LDS_BYTES) != hipSuccess) { fprintf(stderr, "kernel_launch: hipFuncSetAttribute failed\n"); grid = -1; return; }
        if (hipOccupancyMaxActiveBlocksPerMultiprocessor(&per_cu, (const void*)mega_fwd, NWAVES * 64, LDS_BYTES) != hipSuccess || per_cu < 1) fprintf(stderr, "kernel_launch: occupancy query says %d\n", per_cu);
        (void)hipGetLastError();
        grid = cus > 0 ? cus : 256;
    }
    if (grid < 0) return;
    (void)hipMemsetAsync((char*)d_ws + WS_CTL, 0, CTL_BYTES + ADA_BYTES, stream);
    Args a{};
    for (int i = 0; i < 27; ++i) a.in[i] = (const float*)d_in[i];
    a.out = (float*)d_out; a.ws = (unsigned char*)d_ws;
    hipLaunchKernelGGL(mega_fwd, dim3(grid), dim3(NWAVES * 64), LDS_BYTES, stream, a);
}
```

```cpp
#include <hip/hip_runtime.h>
#include <cstdio>
#include <cstdint>
namespace pg8 {
#define PG8_LAS __attribute__((address_space(3)))
typedef unsigned short bf16_t;
typedef short bf16x8 __attribute__((ext_vector_type(8)));
typedef float f32x4 __attribute__((ext_vector_type(4)));
typedef unsigned u32x4 __attribute__((ext_vector_type(4)));
constexpr int BM = 256, BK = 64, HALF = 128, HTB = HALF * BK * 2  , STAGE_BYTES = 8 * HTB, NXCD = 8, WGM = 8;

__host__ __device__ __forceinline__ int lds_byte(int r, int c) { const int st = (r >> 4) * 2 + (c >> 5), rr = r & 15, cc = c & 31, ob = rr * 64 + cc * 2; return st * 1024 + (ob ^ (((ob >> 9) & 1) << 5)); }
__host__ __device__ __forceinline__ void stage_rc(int b, int& R, int& C) { const int st = b / 1024, sb = b % 1024, swz = sb ^ (((sb >> 9) & 1) << 5); R = (st >> 1) * 16 + swz / 64; C = (st & 1) * 32 + (swz % 64) / 2; }
__host__ __device__ __forceinline__ int perm32(int rho) { const int n = rho >> 4, i = rho & 15; return 8 * (i >> 2) + 4 * n + (i & 3); }

struct Unit { int pm, pn, half; };
struct Gemm { const bf16_t* A; const bf16_t* Bt; int M, N, K, pad; };

struct StaticOrder {
    int nM, nN, nwg, G, c, nfull, halves;
    __host__ __device__ __forceinline__ void init(int M, int N, int G_, int c_, int bm = BM) { nM = M / bm; nN = N / BM; nwg = nM * nN; G = G_; c = c_; nfull = (nwg / G) * G; const int rem = nwg - nfull; halves = (bm == BM && rem > 0 && 2 * rem <= G) ? 1 : 0; }
    __host__ __device__ __forceinline__ bool next(int i, Unit& u) const {
        long L = (long)i * G + c; u.half = 0;
        if (halves && L >= nfull) { if (L >= nfull + G) return false; L = nfull + (c >> 1); u.half = 1 + (c & 1); }
        if (L >= nwg) return false;
        int wgid = (int)L; { const int q = nwg / NXCD, r = nwg % NXCD, xcd = wgid % NXCD, off = wgid / NXCD; wgid = (xcd < r ? xcd * (q + 1) : r * (q + 1) + (xcd - r) * q) + off; }
        const int nig = WGM * nN, gid = wgid / nig, fm = gid * WGM, gsz = (nM - fm) < WGM ? (nM - fm) : WGM;
        u.pm = fm + ((wgid % nig) % gsz); u.pn = (wgid % nig) / gsz; return true;
    }
    __device__ __forceinline__ void a_ready(const Unit&) const {}
    __device__ __forceinline__ void done(const Unit&) const {}
};
__device__ __forceinline__ unsigned cvt_pk_bf16(float lo, float hi) { unsigned r; asm volatile("v_cvt_pk_bf16_f32 %0, %1, %2" : "=v"(r) : "v"(lo), "v"(hi)); return r; }
typedef float f32x2 __attribute__((ext_vector_type(2)));
__device__ __forceinline__ float silu_f(float x) { return x * __builtin_amdgcn_rcpf(1.0f + __expf(-x)); }
struct EpiSwiglu {
    static constexpr bool PERM = true, AFTER_DRAIN = false;
    bf16_t* O; int ldc, pad;
    __device__ __forceinline__ void operator()(const f32x4 (&acc)[2][2][4][2], const Unit& u, int wr, int wc, int fr, int fq) const {
        const int row0 = u.pm * BM + wr * 64 + fr + (u.half == 2 ? HALF : 0), col0 = u.pn * HALF + wc * 32 + 8 * fq;
#pragma unroll
        for (int ai = 0; ai < 2; ++ai) { if (ai == 1 && u.half) break;
#pragma unroll
            for (int m = 0; m < 4; ++m) { bf16_t* rowp = O + (size_t)(row0 + ai * HALF + m * 16) * ldc + col0;
                float r[8];
#pragma unroll
                for (int n = 0; n < 2; ++n)
#pragma unroll
                    for (int e = 0; e < 4; ++e) r[n * 4 + e] = silu_f(acc[ai][0][m][n][e]) * acc[ai][1][m][n][e];
                u32x4 w; w.x = cvt_pk_bf16(r[0], r[1]); w.y = cvt_pk_bf16(r[2], r[3]); w.z = cvt_pk_bf16(r[4], r[5]); w.w = cvt_pk_bf16(r[6], r[7]);
                *(u32x4*)rowp = w; } }
    }
};
struct EpiResid {
    static constexpr bool PERM = false, AFTER_DRAIN = false;
    float* X; const float* gate; int ldc, cond_stride; float coef; int pad;
    __device__ __forceinline__ void operator()(const f32x4 (&acc)[2][2][4][2], const Unit& u, int wr, int wc, int fr, int fq) const {
        const int row0 = u.pm * BM + wr * 64 + fr + (u.half == 2 ? HALF : 0), col0 = u.pn * BM + wc * 32 + 4 * fq;
        const int cond = u.pm < 16 ? 0 : (u.pm < 32 ? 1 : 2);
        const float* gp = gate + (size_t)cond * cond_stride + col0;
        f32x4 gv[2][2];
#pragma unroll
        for (int bj = 0; bj < 2; ++bj)
#pragma unroll
            for (int n = 0; n < 2; ++n) gv[bj][n] = *(const f32x4*)(gp + bj * HALF + n * 16) * coef;
#pragma unroll
        for (int ai = 0; ai < 2; ++ai) { if (ai == 1 && u.half) break;
#pragma unroll
            for (int m = 0; m < 4; ++m) { float* rowp = X + (size_t)(row0 + ai * HALF + m * 16) * ldc + col0;
#pragma unroll
                for (int bj = 0; bj < 2; ++bj)
#pragma unroll
                    for (int n = 0; n < 2; ++n) { f32x4* p = (f32x4*)(rowp + bj * HALF + n * 16); *p = *p + gv[bj][n] * acc[ai][bj][m][n]; } } }
    }
};
struct EpiResidTQ {
    static constexpr bool PERM = false, AFTER_DRAIN = false;
    float* X; const float* R0; const float* R1; const float* gate; int ldc, cond_stride; float coef; int pad;
    __device__ __forceinline__ void operator()(const f32x4 (&acc)[2][2][4][2], const Unit& u, int wr, int wc, int fr, int fq) const {
        const int rbase = u.pm * 192, col0 = u.pn * BM + wc * 32 + 4 * fq;
        constexpr int AI[6] = {0, 0, 0, 0, 1, 1}, MM[6] = {0, 1, 2, 3, 0, 1};
        int cur_cond; f32x4 gv[2][2];
        { const int rg0 = rbase + wr * 64; cur_cond = rg0 < 4096 ? 0 : (rg0 < 8192 ? 1 : 2); const float* gp = gate + (size_t)cur_cond * cond_stride + col0;
#pragma unroll
          for (int bj = 0; bj < 2; ++bj)
#pragma unroll
              for (int n = 0; n < 2; ++n) gv[bj][n] = *(const f32x4*)(gp + bj * HALF + n * 16) * coef; }
#pragma unroll
        for (int hb = 0; hb < 2; ++hb) {
            f32x4 xin[3][2][2];
#pragma unroll
            for (int q = 0; q < 3; ++q) { const int g = 3 * hb + q, rg = rbase + (AI[g] ? HALF + wr * 32 : wr * 64) + MM[g] * 16; const float* rowp = (rg < 4096 ? R0 + (size_t)(rg + fr) * ldc : R1 + (size_t)(rg + fr - 4096) * ldc) + col0;
#pragma unroll
                for (int bj = 0; bj < 2; ++bj)
#pragma unroll
                    for (int n = 0; n < 2; ++n) xin[q][bj][n] = *(const f32x4*)(rowp + bj * HALF + n * 16); }
#pragma unroll
            for (int q = 0; q < 3; ++q) { const int g = 3 * hb + q, rg = rbase + (AI[g] ? HALF + wr * 32 : wr * 64) + MM[g] * 16, cond = rg < 4096 ? 0 : (rg < 8192 ? 1 : 2);
                if (cond != cur_cond) { cur_cond = cond; const float* gp = gate + (size_t)cond * cond_stride + col0;
#pragma unroll
                    for (int bj = 0; bj < 2; ++bj)
#pragma unroll
                        for (int n = 0; n < 2; ++n) gv[bj][n] = *(const f32x4*)(gp + bj * HALF + n * 16) * coef; }
                float* rowp = X + (size_t)(rg + fr) * ldc + col0;
#pragma unroll
                for (int bj = 0; bj < 2; ++bj)
#pragma unroll
                    for (int n = 0; n < 2; ++n) *(f32x4*)(rowp + bj * HALF + n * 16) = xin[q][bj][n] + gv[bj][n] * acc[AI[g]][bj][MM[g]][n]; }
        }
    }
};
struct EpiProj {
    static constexpr bool PERM = true, AFTER_DRAIN = false;
    bf16_t* P; float* AB;
    __device__ __forceinline__ void operator()(const f32x4 (&acc)[2][2][4][2], const Unit& u, int wr, int wc, int fr, int fq) const {
        const int row0 = u.pm * BM + wr * 64 + fr + (u.half == 2 ? HALF : 0), col0 = u.pn * BM + wc * 32 + 8 * fq;
        if (u.pn < 22) {
            bf16_t* rowp = P + (size_t)row0 * 5632 + col0;
#pragma unroll
            for (int ai = 0; ai < 2; ++ai) { if (ai == 1 && u.half) break;
#pragma unroll
                for (int m = 0; m < 4; ++m) {
#pragma unroll
                    for (int bj = 0; bj < 2; ++bj) { const f32x4 v0 = acc[ai][bj][m][0], v1 = acc[ai][bj][m][1];
                        u32x4 w; w.x = cvt_pk_bf16(v0[0], v0[1]); w.y = cvt_pk_bf16(v0[2], v0[3]); w.z = cvt_pk_bf16(v1[0], v1[1]); w.w = cvt_pk_bf16(v1[2], v1[3]);
                        *(u32x4*)(rowp + bj * HALF) = w; }
                    rowp += (m == 3 ? (HALF - 48) : 16) * 5632; asm volatile("" : "+v"(rowp)); } }
        } else {
            if (wc == 0 && fq < 2) {
#pragma unroll
                for (int ai = 0; ai < 2; ++ai) { if (ai == 1 && u.half) break;
#pragma unroll
                    for (int m = 0; m < 4; ++m) { float* rowp = AB + (size_t)(row0 + ai * HALF + m * 16) * 16 + 8 * fq;
                        *(f32x4*)rowp = acc[ai][0][m][0]; *(f32x4*)(rowp + 4) = acc[ai][0][m][1]; } }
            }
        }
    }
};
template <class Epi, class Sched, bool ALIGN_EPI = false, bool SP2 = false, bool TQ = false>
__device__ __forceinline__ void gemm_phase(PG8_LAS unsigned char* lds, const Gemm g, const Sched& S, const Epi& E, const int tid) {
    const int wid = __builtin_amdgcn_readfirstlane(tid >> 6), lane = tid & 63, wr = wid >> 2, wc = wid & 3, fr = lane & 15, fq = lane >> 4;
    const int K = g.K, nt = K / BK;
    unsigned voffA[2], voffB[2];
#pragma unroll
    for (int i = 0; i < 2; ++i) { int R, C; stage_rc(tid * 16 + i * 8192, R, C); const int Rb = Epi::PERM ? ((R & ~31) + perm32(R & 31)) : R;
        voffA[i] = (unsigned)(R * K + C) * 2u; voffB[i] = (unsigned)(Rb * K + C) * 2u; }
    const size_t kstep = (size_t)(BK * 2);
    const size_t hstep = (size_t)HALF * K * 2;
    const size_t tstep = 2 * hstep;
    const size_t tstepA = TQ ? (size_t)192 * K * 2 : tstep;
    const unsigned ldsw = (unsigned)wid * 1024u;
    const int aoff = lds_byte(wr * 64 + fr, fq * 8), boff = lds_byte(wc * 32 + fr, fq * 8);
    const int aoff1 = TQ ? lds_byte(wr * 32 + fr, fq * 8) : aoff;
#define PG8_SA(b, h) (((b) * 2 + (h)) * HTB)
#define PG8_SB(b, h) ((4 + (b) * 2 + (h)) * HTB)
#define PG8_STAGE(bufoff, gbase, voff) do { _Pragma("unroll") for (int _i = 0; _i < 2; ++_i) \
        __builtin_amdgcn_global_load_lds((const unsigned*)((const char*)(gbase) + (voff)[_i]), (PG8_LAS unsigned*)(lds + (bufoff) + ldsw + _i * 8192), 16, 0, 0); } while (0)
#define PG8_STAGE_A1(bufoff, gbase, voff) do { if constexpr (TQ) __builtin_amdgcn_global_load_lds((const unsigned*)((const char*)(gbase) + (voff)[0]), (PG8_LAS unsigned*)(lds + (bufoff) + ldsw), 16, 0, 0); else PG8_STAGE(bufoff, gbase, voff); } while (0)
#define PG8_LDA(dst, b, h) do { _Pragma("unroll") for (int m = 0; m < 4; ++m) _Pragma("unroll") for (int k = 0; k < 2; ++k) dst[m][k] = *(const PG8_LAS bf16x8*)(lds + PG8_SA(b, h) + aoff + m * 2048 + k * 1024); } while (0)
#define PG8_LDA2(dst, b, h) do { if constexpr (TQ) { _Pragma("unroll") for (int m = 0; m < 2; ++m) _Pragma("unroll") for (int k = 0; k < 2; ++k) dst[m][k] = *(const PG8_LAS bf16x8*)(lds + PG8_SA(b, h) + aoff1 + m * 2048 + k * 1024); } else PG8_LDA(dst, b, h); } while (0)
#define PG8_LDB(dst, b, h) do { _Pragma("unroll") for (int n = 0; n < 2; ++n) _Pragma("unroll") for (int k = 0; k < 2; ++k) dst[n][k] = *(const PG8_LAS bf16x8*)(lds + PG8_SB(b, h) + boff + n * 2048 + k * 1024); } while (0)
#define PG8_MMA(ai, bj, At, Bt) do { __builtin_amdgcn_s_setprio(1); _Pragma("unroll") for (int m = 0; m < 4; ++m) _Pragma("unroll") for (int n = 0; n < 2; ++n) _Pragma("unroll") for (int k = 0; k < 2; ++k) \
        acc[ai][bj][m][n] = __builtin_amdgcn_mfma_f32_16x16x32_bf16(Bt[n][k], At[m][k], acc[ai][bj][m][n], 0, 0, 0); __builtin_amdgcn_s_setprio(0); } while (0)
#define PG8_MMA2(ai, bj, At, Bt) do { if constexpr (TQ) { __builtin_amdgcn_s_setprio(1); _Pragma("unroll") for (int m = 0; m < 2; ++m) _Pragma("unroll") for (int n = 0; n < 2; ++n) _Pragma("unroll") for (int k = 0; k < 2; ++k) \
        acc[ai][bj][m][n] = __builtin_amdgcn_mfma_f32_16x16x32_bf16(Bt[n][k], At[m][k], acc[ai][bj][m][n], 0, 0, 0); __builtin_amdgcn_s_setprio(0); } else PG8_MMA(ai, bj, At, Bt); } while (0)
#define PG8_WAIT_V(n) asm volatile("s_waitcnt vmcnt(" #n ")" ::: "memory")
#define PG8_WAIT_V8 do { if constexpr (TQ) PG8_WAIT_V(7); else PG8_WAIT_V(8); } while (0)
#define PG8_WAIT_L(n) asm volatile("s_waitcnt lgkmcnt(" #n ")" ::: "memory")
#define PG8_BAR __builtin_amdgcn_s_barrier()
#define PG8_SCHED __builtin_amdgcn_sched_barrier(0)
    Unit cur, nxt; int ui = 0;
    if (!S.next(0, cur)) return;
    f32x4 acc[2][2][4][2];
#pragma unroll
    for (int a = 0; a < 2; ++a)
#pragma unroll
        for (int b = 0; b < 2; ++b)
#pragma unroll
            for (int m = 0; m < 4; ++m)
#pragma unroll
                for (int n = 0; n < 2; ++n) acc[a][b][m][n] = (f32x4){0.f, 0.f, 0.f, 0.f};
    bf16x8 At[4][2], B0[2][2], B1[2][2];
    const char* cA = (const char*)g.A + (size_t)cur.pm * tstepA + (cur.half == 2 ? hstep : 0); const char* cB = (const char*)g.Bt + (size_t)cur.pn * tstep; size_t hA = cur.half ? 0 : hstep;
    S.a_ready(cur);
    if constexpr (SP2) {
        PG8_STAGE(PG8_SB(0, 0), cB, voffB); PG8_STAGE(PG8_SB(0, 1), cB + hstep, voffB); PG8_STAGE(PG8_SA(0, 0), cA, voffA); PG8_STAGE_A1(PG8_SA(0, 1), cA + hA, voffA);
        if (wr == 1) PG8_BAR;
        if constexpr (TQ) PG8_WAIT_V(1); else PG8_WAIT_V(2); PG8_BAR;
        PG8_STAGE(PG8_SB(1, 0), cB + kstep, voffB); PG8_STAGE(PG8_SA(1, 0), cA + kstep, voffA); PG8_STAGE(PG8_SB(1, 1), cB + hstep + kstep, voffB);
        PG8_WAIT_V(6); PG8_BAR;
    } else {
        PG8_STAGE(PG8_SB(0, 0), cB, voffB); PG8_STAGE(PG8_SA(0, 0), cA, voffA); PG8_STAGE(PG8_SB(0, 1), cB + hstep, voffB); PG8_STAGE(PG8_SA(0, 1), cA + hstep, voffA);
        if (wr == 1) PG8_BAR;
        PG8_WAIT_V(4); PG8_BAR;
        PG8_STAGE(PG8_SB(1, 0), cB + kstep, voffB); PG8_STAGE(PG8_SA(1, 0), cA + kstep, voffA); PG8_STAGE(PG8_SB(1, 1), cB + hstep + kstep, voffB);
        PG8_WAIT_V(6); PG8_BAR;
    }
    for (;;) {
        const bool has_next = S.next(ui + 1, nxt);
        const char* nA = has_next ? (const char*)g.A + (size_t)nxt.pm * tstepA + (nxt.half == 2 ? hstep : 0) : cA; const char* nB = has_next ? (const char*)g.Bt + (size_t)nxt.pn * tstep : cB;
        const size_t nhA = has_next ? (nxt.half ? 0 : hstep) : hA; const bool whole = cur.half == 0;
        for (int t = 0; t < nt; t += 2) {
            const bool last = (t == nt - 2);
            const char* a1 = cA + (size_t)(t + 1) * kstep;
            const char* a2 = last ? nA : cA + (size_t)(t + 2) * kstep; const char* b2 = last ? nB : cB + (size_t)(t + 2) * kstep;
            const char* a3 = a2 + kstep; const char* b3 = b2 + kstep;
            if (last && has_next) S.a_ready(nxt);
            if constexpr (SP2) {
            PG8_LDB(B0, 0, 0); PG8_LDB(B1, 0, 1); PG8_SCHED; PG8_LDA(At, 0, 0); PG8_STAGE_A1(PG8_SA(1, 1), a1 + hA, voffA);
            PG8_WAIT_V8; PG8_WAIT_L(0); PG8_BAR; PG8_MMA(0, 0, At, B0); PG8_MMA(0, 1, At, B1); PG8_BAR; PG8_SCHED;
            if (whole) PG8_LDA2(At, 0, 1); PG8_STAGE(PG8_SB(0, 0), b2, voffB); PG8_STAGE(PG8_SB(0, 1), b2 + hstep, voffB); PG8_STAGE(PG8_SA(0, 0), a2, voffA);
            PG8_WAIT_V8; PG8_WAIT_L(0); PG8_BAR; if (whole) { PG8_MMA2(1, 0, At, B0); PG8_MMA2(1, 1, At, B1); } PG8_BAR; PG8_SCHED;
            PG8_LDB(B0, 1, 0); PG8_LDB(B1, 1, 1); PG8_SCHED; PG8_LDA(At, 1, 0); PG8_STAGE_A1(PG8_SA(0, 1), a2 + (last ? nhA : hA), voffA);
            PG8_WAIT_V8; PG8_WAIT_L(0); PG8_BAR; PG8_MMA(0, 0, At, B0); PG8_MMA(0, 1, At, B1); PG8_BAR; PG8_SCHED;
            if (whole) PG8_LDA2(At, 1, 1); PG8_STAGE(PG8_SB(1, 0), b3, voffB); PG8_STAGE(PG8_SB(1, 1), b3 + hstep, voffB); PG8_STAGE(PG8_SA(1, 0), a3, voffA);
            PG8_WAIT_V8; PG8_WAIT_L(0); PG8_BAR; if (whole) { PG8_MMA2(1, 0, At, B0); PG8_MMA2(1, 1, At, B1); } PG8_BAR; PG8_SCHED;
            } else {
            PG8_LDB(B0, 0, 0); PG8_SCHED; PG8_LDA(At, 0, 0); PG8_STAGE(PG8_SA(1, 1), a1 + hstep, voffA);
            PG8_WAIT_L(8); PG8_BAR; PG8_WAIT_L(0); PG8_MMA(0, 0, At, B0); PG8_BAR; PG8_SCHED;
            PG8_LDB(B1, 0, 1); PG8_STAGE(PG8_SB(0, 0), b2, voffB);
            PG8_BAR; PG8_WAIT_L(0); PG8_MMA(0, 1, At, B1); PG8_BAR;
            PG8_LDA(At, 0, 1); PG8_STAGE(PG8_SA(0, 0), a2, voffA);
            PG8_BAR; PG8_WAIT_L(0); PG8_MMA(1, 0, At, B0); PG8_BAR; PG8_SCHED;
            PG8_STAGE(PG8_SB(0, 1), b2 + hstep, voffB);
            PG8_WAIT_V(6); PG8_BAR; PG8_MMA(1, 1, At, B1); PG8_BAR;
            PG8_LDB(B0, 1, 0); PG8_SCHED; PG8_LDA(At, 1, 0); PG8_STAGE(PG8_SA(0, 1), a2 + hstep, voffA);
            PG8_WAIT_L(8); PG8_BAR; PG8_WAIT_L(0); PG8_MMA(0, 0, At, B0); PG8_BAR; PG8_SCHED;
            PG8_LDB(B1, 1, 1); PG8_STAGE(PG8_SB(1, 0), b3, voffB);
            PG8_BAR; PG8_WAIT_L(0); PG8_MMA(0, 1, At, B1); PG8_BAR;
            PG8_LDA(At, 1, 1); PG8_STAGE(PG8_SA(1, 0), a3, voffA);
            PG8_BAR; PG8_WAIT_L(0); PG8_MMA(1, 0, At, B0); PG8_BAR; PG8_SCHED;
            PG8_STAGE(PG8_SB(1, 1), b3 + hstep, voffB);
            PG8_WAIT_V(6); PG8_BAR; PG8_MMA(1, 1, At, B1); PG8_BAR;
            }
        }
        if constexpr (ALIGN_EPI) { if (wr == 0) PG8_BAR; }
        if constexpr (!Epi::AFTER_DRAIN) { E(acc, cur, wr, wc, fr, fq); S.done(cur); }
        if (!has_next) break;
#pragma unroll
        for (int a = 0; a < 2; ++a)
#pragma unroll
            for (int b = 0; b < 2; ++b)
#pragma unroll
                for (int m = 0; m < 4; ++m)
#pragma unroll
                    for (int n = 0; n < 2; ++n) acc[a][b][m][n] = (f32x4){0.f, 0.f, 0.f, 0.f};
        cur = nxt; cA = nA; cB = nB; hA = nhA; ++ui;
        if constexpr (ALIGN_EPI) { if (wr == 1) PG8_BAR; }
    }
    PG8_WAIT_V(0);
    if constexpr (!ALIGN_EPI) { if (wr == 0) PG8_BAR; }
    PG8_BAR;
    if constexpr (Epi::AFTER_DRAIN) { E.fused(acc, cur, wr, wc, fr, fq, lds, wid, lane); S.done(cur); }
#undef PG8_SA
#undef PG8_SB
#undef PG8_STAGE
#undef PG8_LDA
#undef PG8_LDB
#undef PG8_MMA
#undef PG8_WAIT_V
#undef PG8_WAIT_L
#undef PG8_BAR
#undef PG8_SCHED
}
}
#define GAS __attribute__((address_space(1)))
#define XB_TMO      128
#define XB_XCNT(j)  (256  + 64 * (j))
#define XB_XSUB(j)  (1280 + 64 * (j))
#define XB_XGEN(j)  (2304 + 64 * (j))
#define XB_TOP      3328
#define XB_TOPGEN   3392
#define XCD_BAR_WORDS 3456
#define XB_SPIN_CAP (1u << 18)
#define LAS __attribute__((address_space(3)))

__device__ __forceinline__ unsigned xb_ld(unsigned* p)              { return __hip_atomic_load(p, __ATOMIC_RELAXED, __HIP_MEMORY_SCOPE_AGENT); }
__device__ __forceinline__ unsigned xb_add(unsigned* p, unsigned v) { return __hip_atomic_fetch_add(p, v, __ATOMIC_RELAXED, __HIP_MEMORY_SCOPE_AGENT); }
__device__ __forceinline__ unsigned xb_xcc_id() { return (unsigned)__builtin_amdgcn_s_getreg((3 << 11) | 20) & 0xFu; }
#define XB_SPIN(cond, bar) do { unsigned _sp = 0; while (cond) { __builtin_amdgcn_s_sleep(1); \
    if ((++_sp & 255u) == 0u) { if (xb_ld(&(bar)[XB_TMO])) break; if (_sp > XB_SPIN_CAP) { atomicAdd(&(bar)[XB_TMO], 1u); break; } } } } while (0)

struct XcdBarrier {
    unsigned* bar; unsigned x;
    volatile LAS unsigned* st;
};

__device__ __forceinline__ XcdBarrier xcd_barrier_post(unsigned* bar, volatile LAS unsigned* st) {
    XcdBarrier b; b.bar = bar; b.x = xb_xcc_id(); b.st = st;
    if (threadIdx.x == 0) (void)xb_add(&bar[XB_XCNT(b.x)], 1u);
    return b;
}
__device__ __forceinline__ void xcd_barrier_complete(unsigned* bar, unsigned x, unsigned& nloc, unsigned& nx) {
    const unsigned G = gridDim.x * gridDim.y * gridDim.z;
    unsigned sum, cnt, mine, sp = 0u;
    for (;;) {
        sum = 0u; cnt = 0u; mine = 0u;
#pragma unroll
        for (unsigned j = 0; j < 16; ++j) { const unsigned c = xb_ld(&bar[XB_XCNT(j)]); sum += c; cnt += (c > 0u) ? 1u : 0u; mine = (j == x) ? c : mine; }
        if (sum == G) break;
        __builtin_amdgcn_s_sleep(1);
        if ((++sp & 255u) == 0u) { if (xb_ld(&bar[XB_TMO])) break; if (sp > XB_SPIN_CAP) { atomicAdd(&bar[XB_TMO], 1u); break; } }
    }
    nloc = mine > 0u ? mine : 1u; nx = cnt > 0u ? cnt : 1u;
}

__device__ __forceinline__ void xcd_barrier(const XcdBarrier& b, const int tid_) {
    asm volatile("s_waitcnt vmcnt(0)" ::: "memory");
    __syncthreads();
    if (tid_ == 0) {
        unsigned* bar = b.bar;
        __builtin_amdgcn_s_waitcnt(0);
        unsigned nloc = b.st[0], nx = b.st[1];
        if (nloc == 0u) { xcd_barrier_complete(bar, b.x, nloc, nx); b.st[0] = nloc; b.st[1] = nx; }
        const unsigned old = xb_add(&bar[XB_XSUB(b.x)], 1u);
        const unsigned gen = old / nloc;
        if (old + 1u == (gen + 1u) * nloc) {
            __builtin_amdgcn_fence(__ATOMIC_RELEASE, "agent");
            asm volatile("s_waitcnt vmcnt(0)" ::: "memory");
            const unsigned og = xb_add(&bar[XB_TOP], 1u);
            const unsigned tg = og / nx;
            if (og + 1u == (tg + 1u) * nx) xb_add(&bar[XB_TOPGEN], 1u);
            else XB_SPIN(xb_ld(&bar[XB_TOPGEN]) == tg, bar);
            __builtin_amdgcn_fence(__ATOMIC_ACQUIRE, "agent");
            xb_add(&bar[XB_XGEN(b.x)], 1u);
            asm volatile("s_waitcnt vmcnt(0)" ::: "memory");
        } else {
            XB_SPIN(xb_ld(&bar[XB_XGEN(b.x)]) == gen, bar);
            __builtin_amdgcn_fence(__ATOMIC_ACQUIRE, "agent");
            asm volatile("s_waitcnt vmcnt(0)" ::: "memory");
        }
    }
    __syncthreads();
}

typedef unsigned short bf16_t;
typedef unsigned u32x4_t __attribute__((ext_vector_type(4)));
typedef float f32x4_t __attribute__((ext_vector_type(4)));
constexpr int D = 2048, MCTX = 4096, MLAT = 8192, M = MCTX + MLAT, DFF = 5632, NFF = 2 * DFF, PROJW = 5632, NPROJ = 5888, IN_COLS = 5648, ADA_N = 9 * D;
constexpr int DEPTH = 2, PAST = 512, LK_LAT = PAST + 4096;
constexpr float EPS = 1e-6f;
constexpr size_t MiB = 1u << 20;
constexpr size_t WS_CTL = 0, CTL_BYTES = 1 * MiB, WS_ADA = 1 * MiB, ADA_BYTES = (size_t)2 * 3 * ADA_N * 4, WS_LAM = 2 * MiB, WS_W = 16 * MiB;
constexpr size_t W_1IN = 0, W_1OUT = W_1IN + (size_t)NFF * D * 2, W_2IN = W_1OUT + (size_t)D * DFF * 2, W_2OUT = W_2IN + (size_t)NFF * D * 2, W_IN = W_2OUT + (size_t)D * DFF * 2,
                 W_OUT = W_IN + (size_t)NPROJ * D * 2, W_LAYER = W_OUT + (size_t)D * D * 2;
static_assert(WS_W + 2 * W_LAYER <= 344 * MiB, "weights");
constexpr size_t WS_X = 344 * MiB, WS_H = 440 * MiB, WS_CAT = 488 * MiB, WS_ACT = 536 * MiB, WS_PROJ = 668 * MiB, WS_AB = 800 * MiB, WS_GQ = 801 * MiB, WS_GK = 825 * MiB, WS_GV = 849 * MiB,
                 WS_GG = 873 * MiB, WS_GB = WS_GG + 512 * 1024, WS_OF = 874 * MiB, WS_OB = 898 * MiB, WS_QB = 922 * MiB, WS_KB = 938 * MiB, WS_VTL = 956 * MiB, WS_VTC = 1112 * MiB, WS_END = 1120 * MiB;
constexpr size_t OUT_YP = 0, OUT_YS = 8388608, OUT_CK = 25165824, OUT_CV = 33554432, OUT_ST = 41943040, OUT_TOTAL = 46137344;
constexpr int CW_BAR = 4096, CW_QUEUE = 16384;
constexpr int LDS_MISC = 147200, LDS_BYTES = 147456;
constexpr int NWAVES = 8;

__device__ __forceinline__ float bf2f(bf16_t b) { return __uint_as_float(((unsigned)b) << 16); }
__device__ __forceinline__ unsigned f2bf(float f) { unsigned u = __float_as_uint(f); return (u + 0x7fffu + ((u >> 16) & 1u)) >> 16; }
__device__ __forceinline__ unsigned pk2(float lo, float hi) { return f2bf(lo) | (f2bf(hi) << 16); }
__device__ __forceinline__ float lane_get(float v, int src_lane) { return __int_as_float(__builtin_amdgcn_ds_bpermute(src_lane << 2, __float_as_int(v))); }
__device__ __forceinline__ float wave_sum(float v, int lane) {
#pragma unroll
    for (int o = 1; o < 64; o <<= 1) v += lane_get(v, lane ^ o);
    return v;
}
__device__ __forceinline__ float silu(float x) { return x * __builtin_amdgcn_rcpf(1.0f + __expf(-x)); }
#define LDS_WAIT() asm volatile("s_waitcnt lgkmcnt(0)" ::: "memory")
__device__ __forceinline__ void row_geom(int row, int& seq0, int& L, int& t) { if (row < MCTX) { seq0 = row & ~255; L = 256; t = row & 255; } else { const int r = row - MCTX; seq0 = MCTX + (r & ~4095); L = 4096; t = r & 4095; } }

__device__ __forceinline__ int fresh_tid_w(int wave_s) { int t; asm volatile("v_mbcnt_lo_u32_b32 %0, -1, 0\n\tv_mbcnt_hi_u32_b32 %0, -1, %0" : "=v"(t)); return wave_s * 64 + t; }
struct Args { const float* in[27]; float* out; unsigned char* ws; };
struct Ptrs {
    const float *x_prompt, *x_sample, *c, *cache_k, *cache_v, *state_gdn, *c_ctx, *w_ada, *b_ada, *norm_ffn1, *ffn1_in, *ffn1_out, *norm_mix, *w_in, *gdn_conv, *gdn_a_log, *gdn_dt_bias, *gdn_norm,
                *diff_lam, *diff_norm, *pool_w, *pool_scale, *w_out, *norm_ffn2, *ffn2_in, *ffn2_out, *final_norm;
};

__device__ __forceinline__ int colmap(int mode, int n) {
    if (mode == 1) { const int t = n >> 8, r = n & 255; return r < 128 ? 128 * t + r : DFF + 128 * t + (r - 128); }
    if (mode == 2) { return n < 2048 ? n : (n < 5632 ? n + 16 : (n < 5648 ? 2048 + (n - 5632) : -1)); }
    return n;
}
typedef float f32x2pf_t __attribute__((ext_vector_type(2)));
__device__ __forceinline__ void tr_item(const float* __restrict__ src, int ld, bf16_t* __restrict__ dst, int Kdst, int mode, int item, int nblk, LAS float* scr, int lane,
                                        const float* __restrict__ pool_w, const float* __restrict__ pool_scale) {
    const int kb = item / nblk, nb = item - kb * nblk, k0 = 64 * kb, n0 = 32 * nb, nn = lane & 31, kh = lane >> 5;
    if (mode == 3 && k0 >= 1536) {
        const int gc0 = k0 - 1536, g = gc0 >> 7, ml = lane & 15, kq = lane >> 4;
        f32x4_t acc[4][2];
#pragma unroll
        for (int mt = 0; mt < 4; ++mt) { acc[mt][0] = (f32x4_t){0.f, 0.f, 0.f, 0.f}; acc[mt][1] = (f32x4_t){0.f, 0.f, 0.f, 0.f}; }
        const float* Ab = pool_w + (size_t)(gc0 + ml) * 128 + 4 * kq; const float* Sb = pool_scale + g * 128 + 4 * kq; const float* Bb = src + (size_t)(1536 + g * 128 + 4 * kq) * ld + n0 + 2 * ml;
#pragma unroll
        for (int s = 0; s < 8; ++s) { const f32x4_t sc4 = *(const f32x4_t*)(Sb + 16 * s); f32x4_t a4[4]; f32x2pf_t b2[4];
#pragma unroll
            for (int mt = 0; mt < 4; ++mt) a4[mt] = *(const f32x4_t*)(Ab + (size_t)mt * 16 * 128 + 16 * s) * sc4;
#pragma unroll
            for (int e = 0; e < 4; ++e) b2[e] = *(const f32x2pf_t*)(Bb + (size_t)(16 * s + e) * ld);
#pragma unroll
            for (int e = 0; e < 4; ++e)
#pragma unroll
                for (int mt = 0; mt < 4; ++mt) { acc[mt][0] = __builtin_amdgcn_mfma_f32_16x16x4f32(a4[mt][e], b2[e].x, acc[mt][0], 0, 0, 0); acc[mt][1] = __builtin_amdgcn_mfma_f32_16x16x4f32(a4[mt][e], b2[e].y, acc[mt][1], 0, 0, 0); } }
#pragma unroll
        for (int mt = 0; mt < 4; ++mt)
#pragma unroll
            for (int e = 0; e < 4; ++e) { scr[(16 * mt + 4 * kq + e) * 33 + 2 * ml] = acc[mt][0][e]; scr[(16 * mt + 4 * kq + e) * 33 + 2 * ml + 1] = acc[mt][1][e]; }
    } else {
        const int sc = colmap(mode == 3 ? 0 : mode, n0 + nn);
        float v[32];
#pragma unroll
        for (int i = 0; i < 32; ++i) v[i] = sc >= 0 ? __builtin_nontemporal_load(src + (size_t)(k0 + 2 * i + kh) * ld + sc) : 0.f;
#pragma unroll
        for (int i = 0; i < 32; ++i) scr[(2 * i + kh) * 33 + nn] = v[i];
    }
    LDS_WAIT();
    const int c = lane & 7;
#pragma unroll
    for (int j = 0; j < 4; ++j) { const int n = (lane >> 3) + 8 * j; const LAS float* s = scr + (8 * c) * 33 + n;
        u32x4_t o; o.x = pk2(s[0 * 33], s[1 * 33]); o.y = pk2(s[2 * 33], s[3 * 33]); o.z = pk2(s[4 * 33], s[5 * 33]); o.w = pk2(s[6 * 33], s[7 * 33]);
        *(u32x4_t*)(dst + (size_t)(n0 + n) * Kdst + k0 + 8 * c) = o; }
    LDS_WAIT();
}
constexpr int I_FIN = (D / 64) * (NFF / 32), I_FOUT = (DFF / 64) * (D / 32), I_WIN = (D / 64) * (NPROJ / 32), I_WOUT = (D / 64) * (D / 32), I_LAYER = 2 * I_FIN + 2 * I_FOUT + I_WIN + I_WOUT;
constexpr int DEFER_T = 8, SEG_F = 1024 * DEFER_T, SEG_W = 768 * DEFER_T, DEFER_ALL = I_LAYER - 512;
constexpr int DSEG0 = 0, DSEG1 = SEG_F, DSEG2 = SEG_F + SEG_W, DSEG3 = 2 * SEG_F + SEG_W, DSEG4 = 3 * SEG_F + SEG_W, DSEG5 = 3 * SEG_F + 2 * SEG_W, DSEG6 = DEFER_ALL;
constexpr int DM1 = I_FIN, DM2 = DM1 + I_FOUT, DM3 = DM2 + I_WIN, DM4 = DM3 + I_FIN, DM5 = DM4 + 1536;
static_assert(DSEG5 <= DSEG6 && DSEG6 - DSEG5 <= SEG_F, "last segment fits its tail");
static_assert(DM1 <= DSEG3, "layer 1 ffn1_in is complete after layer 0");
static_assert(DM2 <= DSEG4 && DM3 <= DSEG4, "ffn1_out and w_in are complete after layer 1's FFN1-in tail");
static_assert(DM4 <= DSEG5 && DM5 <= DSEG5, "ffn2_in and w_out are complete after layer 1's w_in tail");
__device__ __forceinline__ void ph_prologue(const Ptrs& p, unsigned char* ws, LAS unsigned char* lds, int gw, int NGW, int wave, int lane, int tid) {
    LAS float* sc = (LAS float*)lds;
    for (int i = tid; i < 3 * D; i += NWAVES * 64) { const int ci = i >> 11, k = i & 2047; sc[i] = silu(ci == 0 ? p.c_ctx[k] : p.c[(ci - 1) * D + k]); }
    __syncthreads();
    float* ada = (float*)(ws + WS_ADA);
    for (int it = gw; it < 2 * 144 * 32; it += NGW) {
        const int l = it / 4608, r = it - l * 4608, jb = r >> 5, ks = r & 31, j = jb * 128 + 2 * lane;
        const float* w = p.w_ada + ((size_t)l * D + ks * 64) * ADA_N + j;
        f32x2pf_t a0 = {0.f, 0.f}, a1 = {0.f, 0.f}, a2 = {0.f, 0.f};
#pragma unroll 16
        for (int k = 0; k < 64; ++k) { const f32x2pf_t wv = __builtin_nontemporal_load((const f32x2pf_t*)(w + (size_t)k * ADA_N)); a0 += wv * sc[ks * 64 + k]; a1 += wv * sc[D + ks * 64 + k]; a2 += wv * sc[2 * D + ks * 64 + k]; }
        if (ks == 0) { const f32x2pf_t b = *(const f32x2pf_t*)(p.b_ada + l * ADA_N + j); a0 += b; a1 += b; a2 += b; }
        float* o = ada + (size_t)l * 3 * ADA_N + j;
        atomicAdd(o, a0.x); atomicAdd(o + 1, a0.y); atomicAdd(o + ADA_N, a1.x); atomicAdd(o + ADA_N + 1, a1.y); atomicAdd(o + 2 * ADA_N, a2.x); atomicAdd(o + 2 * ADA_N + 1, a2.y);
    }
    if (gw == 0) {
        float* lam = (float*)(ws + WS_LAM);
        for (int l = 0; l < DEPTH; ++l) { const float* v = p.diff_lam + l * 256;
            const float s1 = wave_sum(v[lane] * v[64 + lane], lane), s2 = wave_sum(v[128 + lane] * v[192 + lane], lane);
            const float lam_init = 0.8f - 0.6f * expf(-0.3f * (float)l);
            if (lane == 0) { lam[l * 2] = expf(s1) - expf(s2) + lam_init; lam[l * 2 + 1] = lam_init; } }
    }
    LAS float* scr = (LAS float*)(lds + 24576 + wave * 8448);
    const int skip = NGW == 256 * NWAVES ? DEFER_ALL : 0;
    for (int it = gw; it < 2 * I_LAYER - skip; it += NGW) {
        const int l = it >= I_LAYER ? 1 : 0; int r = l ? it - I_LAYER + skip : it; unsigned char* Wl = ws + WS_W + (size_t)l * W_LAYER;
        if (r < I_FIN) { tr_item(p.ffn1_in + (size_t)l * D * NFF, NFF, (bf16_t*)(Wl + W_1IN), D, 1, r, NFF / 32, scr, lane, nullptr, nullptr); continue; } r -= I_FIN;
        if (r < I_FIN) { tr_item(p.ffn2_in + (size_t)l * D * NFF, NFF, (bf16_t*)(Wl + W_2IN), D, 1, r, NFF / 32, scr, lane, nullptr, nullptr); continue; } r -= I_FIN;
        if (r < I_FOUT) { tr_item(p.ffn1_out + (size_t)l * DFF * D, D, (bf16_t*)(Wl + W_1OUT), DFF, 0, r, D / 32, scr, lane, nullptr, nullptr); continue; } r -= I_FOUT;
        if (r < I_FOUT) { tr_item(p.ffn2_out + (size_t)l * DFF * D, D, (bf16_t*)(Wl + W_2OUT), DFF, 0, r, D / 32, scr, lane, nullptr, nullptr); continue; } r -= I_FOUT;
        if (r < I_WIN) { tr_item(p.w_in + (size_t)l * D * IN_COLS, IN_COLS, (bf16_t*)(Wl + W_IN), D, 2, r, NPROJ / 32, scr, lane, nullptr, nullptr); continue; } r -= I_WIN;
        tr_item(p.w_out + (size_t)l * D * D, D, (bf16_t*)(Wl + W_OUT), D, 3, r, D / 32, scr, lane, p.pool_w + (size_t)l * 4 * 128 * 128, p.pool_scale + (size_t)l * 512);
    }
}
__device__ __forceinline__ void norm_row(const float* __restrict__ xrow, int row, const float* __restrict__ gain, const float* __restrict__ shift, const float* __restrict__ scale, bf16_t* __restrict__ H, float* xcopy, int lane) {
    const int cond = row < MCTX ? 0 : (row < MCTX + 4096 ? 1 : 2);
    const f32x4_t* xr = (const f32x4_t*)xrow + lane;
    const f32x4_t* gp = (const f32x4_t*)gain + lane; const f32x4_t* sh = (const f32x4_t*)(shift + (size_t)cond * ADA_N) + lane; const f32x4_t* sc = (const f32x4_t*)(scale + (size_t)cond * ADA_N) + lane;
    f32x4_t v[8], gq[8], aq[8], bq[8]; float ss = 0.f;
#pragma unroll
    for (int j = 0; j < 8; ++j) v[j] = xr[64 * j];
#pragma unroll
    for (int j = 0; j < 8; ++j) { gq[j] = gp[64 * j]; aq[j] = sh[64 * j]; bq[j] = sc[64 * j]; }
#pragma unroll
    for (int j = 0; j < 8; ++j) ss += (v[j].x * v[j].x + v[j].y * v[j].y) + (v[j].z * v[j].z + v[j].w * v[j].w);
    const float rstd = rsqrtf(wave_sum(ss, lane) * (1.0f / D) + EPS);
    if (xcopy) { f32x4_t* xc = (f32x4_t*)(xcopy + (size_t)row * D) + lane;
#pragma unroll
        for (int j = 0; j < 8; ++j) xc[64 * j] = v[j]; }
    unsigned long long* o8 = (unsigned long long*)(H + (size_t)row * D) + lane;
#pragma unroll
    for (int j = 0; j < 8; ++j) { const f32x4_t g = gq[j], a = aq[j], b = bq[j]; const f32x4_t y = v[j] * rstd * g * (b + 1.0f) + a;
        o8[64 * j] = (unsigned long long)pk2(y.x, y.y) | ((unsigned long long)pk2(y.z, y.w) << 32); }
}
__device__ __forceinline__ void final_norm_row(const float* __restrict__ X, int row, const float* __restrict__ gain, float* __restrict__ out, int lane) {
    const f32x4_t* xr = (const f32x4_t*)(X + (size_t)row * D) + lane; const f32x4_t* gp = (const f32x4_t*)gain + lane;
    f32x4_t v[8], gq[8]; float ss = 0.f;
#pragma unroll
    for (int j = 0; j < 8; ++j) v[j] = xr[64 * j];
#pragma unroll
    for (int j = 0; j < 8; ++j) gq[j] = gp[64 * j];
#pragma unroll
    for (int j = 0; j < 8; ++j) ss += (v[j].x * v[j].x + v[j].y * v[j].y) + (v[j].z * v[j].z + v[j].w * v[j].w);
    const float rstd = rsqrtf(wave_sum(ss, lane) * (1.0f / D) + EPS);
    f32x4_t* o = (f32x4_t*)(out + (size_t)row * D) + lane;
#pragma unroll
    for (int j = 0; j < 8; ++j) o[64 * j] = v[j] * rstd * gq[j];
}
__device__ __forceinline__ void unpack8(u32x4_t w, float (&f)[8]) { f[0] = __uint_as_float(w.x << 16); f[1] = __uint_as_float(w.x & 0xffff0000u); f[2] = __uint_as_float(w.y << 16); f[3] = __uint_as_float(w.y & 0xffff0000u);
    f[4] = __uint_as_float(w.z << 16); f[5] = __uint_as_float(w.z & 0xffff0000u); f[6] = __uint_as_float(w.w << 16); f[7] = __uint_as_float(w.w & 0xffff0000u); }
__device__ __forceinline__ u32x4_t pack8f(const float (&f)[8]) { u32x4_t w; w.x = pk2(f[0], f[1]); w.y = pk2(f[2], f[3]); w.z = pk2(f[4], f[5]); w.w = pk2(f[6], f[7]); return w; }
__device__ __forceinline__ void rope_load(int r, const bf16_t* __restrict__ P, int lane, u32x4_t (&xr)[4]) {
    const size_t prow = (size_t)(MCTX + r) * PROJW;
#pragma unroll
    for (int i = 0; i < 2; ++i) { const int task = lane + 64 * i, which = task >> 6, grp = (task >> 1) & 31, hj = task & 1, col = grp * 32 + 8 * hj;
        const bf16_t* src = P + prow + (which ? 3072 : 2048) + col; xr[2 * i] = *(const u32x4_t*)src; xr[2 * i + 1] = *(const u32x4_t*)(src + 16); }
}
__device__ __forceinline__ void rope_finish(int r, const u32x4_t (&xr)[4], bf16_t* __restrict__ QB, bf16_t* __restrict__ KB, const LAS float* tab, int lane) {
    const int b = r >> 12, t = r & 4095;
#pragma unroll
    for (int i = 0; i < 2; ++i) { const int task = lane + 64 * i, which = task >> 6, grp = (task >> 1) & 31, hj = task & 1, col = grp * 32 + 8 * hj;
        const int pos = (grp & 1) ? (t & 63) : (t >> 6);
        float x1[8], x2[8], o1[8], o2[8]; unpack8(xr[2 * i], x1); unpack8(xr[2 * i + 1], x2);
        const LAS float* tp = tab + (pos * 16 + 8 * hj) * 2;
#pragma unroll
        for (int e = 0; e < 8; ++e) { const float cs = tp[2 * e], sn = tp[2 * e + 1]; o1[e] = x1[e] * cs - x2[e] * sn; o2[e] = x1[e] * sn + x2[e] * cs; }
        bf16_t* dst = which ? KB + ((size_t)b * LK_LAT + PAST + t) * 1024 + col : QB + (size_t)r * 1024 + col;
        *(u32x4_t*)dst = pack8f(o1); *(u32x4_t*)(dst + 16) = pack8f(o2); }
}
__device__ __forceinline__ void pool_load(int row, const bf16_t* __restrict__ P, int lane, u32x4_t (&tap)[16]) {
    int seq0, L, t; row_geom(row, seq0, L, t);
    const int w = 2 << (lane >> 4), a = w >> 1, bb = w - a - 1, lo = t - a < 0 ? 0 : t - a, hi = t + bb + 1 > L ? L : t + bb + 1;
#pragma unroll
    for (int o = 0; o < 16; ++o) { const int tt = t + o - 8; tap[o] = *(const u32x4_t*)(P + (size_t)(seq0 + ((tt >= lo && tt < hi) ? tt : t)) * PROJW + 5120 + 8 * lane); }
}
__device__ __forceinline__ void pool_finish(int row, const u32x4_t (&tap)[16], bf16_t* __restrict__ CAT, int lane) {
    int seq0, L, t; row_geom(row, seq0, L, t);
    const int w = 2 << (lane >> 4), a = w >> 1, bb = w - a - 1, lo = t - a < 0 ? 0 : t - a, hi = t + bb + 1 > L ? L : t + bb + 1;
    float s[8], x[8];
#pragma unroll
    for (int e = 0; e < 8; ++e) s[e] = 0.f;
#pragma unroll
    for (int o = 0; o < 16; ++o) { const int tt = t + o - 8; const float wgt = (tt >= lo && tt < hi) ? 1.0f : 0.0f; float v[8]; unpack8(tap[o], v);
#pragma unroll
        for (int e = 0; e < 8; ++e) s[e] += v[e] * wgt; }
    unpack8(tap[8], x);
    const float inv = 1.0f / (float)(hi - lo);
#pragma unroll
    for (int e = 0; e < 8; ++e) s[e] = s[e] * inv - x[e];
    *(u32x4_t*)(CAT + (size_t)row * D + 1536 + 8 * lane) = pack8f(s);
}
__device__ __forceinline__ void gdn_out_row(int row, const float* __restrict__ OF, const float* __restrict__ OB, const bf16_t* __restrict__ P, const float* __restrict__ gnorm, bf16_t* __restrict__ CAT, int lane) {
    const size_t o = (size_t)row * 512 + 8 * lane; const int c0 = 8 * (lane & 15);
    const f32x4_t f0 = *(const f32x4_t*)(OF + o), f1 = *(const f32x4_t*)(OF + o + 4), b0 = *(const f32x4_t*)(OB + o), b1 = *(const f32x4_t*)(OB + o + 4);
    const u32x4_t zr = *(const u32x4_t*)(P + (size_t)row * PROJW + 1536 + 8 * lane);
    const f32x4_t g0 = *(const f32x4_t*)(gnorm + c0), g1 = *(const f32x4_t*)(gnorm + c0 + 4);
    const f32x4_t x0 = f0 + b0, x1 = f1 + b1;
    float ss = ((x0.x * x0.x + x0.y * x0.y) + (x0.z * x0.z + x0.w * x0.w)) + ((x1.x * x1.x + x1.y * x1.y) + (x1.z * x1.z + x1.w * x1.w));
    ss += lane_get(ss, lane ^ 1); ss += lane_get(ss, lane ^ 2); ss += lane_get(ss, lane ^ 4); ss += lane_get(ss, lane ^ 8);
    const float r = rsqrtf(ss * (1.0f / 128.0f) + EPS);
    float z[8], y[8]; unpack8(zr, z);
    y[0] = x0.x * r * g0.x * silu(z[0]); y[1] = x0.y * r * g0.y * silu(z[1]); y[2] = x0.z * r * g0.z * silu(z[2]); y[3] = x0.w * r * g0.w * silu(z[3]);
    y[4] = x1.x * r * g1.x * silu(z[4]); y[5] = x1.y * r * g1.y * silu(z[5]); y[6] = x1.z * r * g1.z * silu(z[6]); y[7] = x1.w * r * g1.w * silu(z[7]);
    *(u32x4_t*)(CAT + (size_t)row * D + 8 * lane) = pack8f(y);
}
constexpr int GBLK_W = 0, GBLK_Q = 16384, GBLK_K = 32768, GBLK_A = 49152, GBLK_U = 57344, GBLK_GL = 90112, GBLK_BYTES = 92160, GBLK_DMA = 57344;
constexpr size_t WS_GBLK = 974 * MiB;
static_assert(WS_GBLK + (size_t)1536 * GBLK_BYTES <= 1152 * MiB, "gdn blocks");
typedef short bf16x8_t __attribute__((ext_vector_type(8)));
typedef __bf16 bf16x2v_t __attribute__((ext_vector_type(2)));
typedef float f32x2v_t __attribute__((ext_vector_type(2)));
__device__ __forceinline__ unsigned cvt2(float lo, float hi) { f32x2v_t v = {lo, hi}; bf16x2v_t b = __builtin_convertvector(v, bf16x2v_t); return __builtin_bit_cast(unsigned, b); }
__device__ __forceinline__ bf16x8_t pack8(f32x4_t a, f32x4_t b) { u32x4_t w; w.x = cvt2(a.x, a.y); w.y = cvt2(a.z, a.w); w.z = cvt2(b.x, b.y); w.w = cvt2(b.z, b.w); return __builtin_bit_cast(bf16x8_t, w); }
__device__ __forceinline__ int img_byte(int r, int c) { const int st = (r >> 4) * 2 + (c >> 5), rr = r & 15, cc = c & 31, ob = rr * 64 + cc * 2; return st * 1024 + (ob ^ (((ob >> 9) & 1) << 5)); }
__device__ __forceinline__ int posinv(int x) { const int g = x & ~31, y = x & 31; return g + 8 * ((y >> 2) & 3) + 4 * (y >> 4) + (y & 3); }
__device__ __forceinline__ int gdn_block_index(int b, int dir, int h, int n, bool lat) { return lat ? 512 + (((b * 2 + dir) * 4 + h) * 64 + n) : ((b * 2 + dir) * 4 + h) * 4 + n; }

__device__ __forceinline__ void gdn_prep_item(int item, const bf16_t* __restrict__ P, const float* __restrict__ AB, const float* __restrict__ conv, const float* __restrict__ a_log, const float* __restrict__ dt_bias,
                                              unsigned char* __restrict__ gblk, LAS unsigned char* lds, int tid) {
    asm volatile("" : "+v"(tid));
    int vz = 0; asm volatile("" : "+v"(vz));
    LAS float* kf = (LAS float*)lds + vz; LAS float* vf = kf + 64 * 132; LAS unsigned char* R2 = (LAS unsigned char*)(vf + 64 * 132); LAS float* R3 = (LAS float*)(R2 + 32768); LAS float* sm = R3 + 8192;
    int b, nb, h, seq0, NC; bool lat;
    if (item < 256) { lat = false; b = item >> 4; nb = (item >> 2) & 3; h = item & 3; seq0 = b * 256; NC = 4; }
    else { const int i2 = item - 256; lat = true; b = i2 >> 8; nb = (i2 >> 2) & 63; h = i2 & 3; seq0 = MCTX + b * 4096; NC = 64; }
    const int t0 = nb * 64, Lseq = NC * 64;
    unsigned char* blk0 = gblk + (size_t)gdn_block_index(b, 0, h, nb, lat) * GBLK_BYTES;
    unsigned char* blk1 = gblk + (size_t)gdn_block_index(b, 1, h, NC - 1 - nb, lat) * GBLK_BYTES;
    const int lane = tid & 63, wave = tid >> 6, fr = lane & 15, fq = lane >> 4;
    __syncthreads();
    u32x4_t xr[6][4];
#pragma unroll
    for (int i = 0; i < 6; ++i) { const int id = tid + 512 * i, c = id / 48, r48 = id - c * 48, part = r48 >> 4, ch8 = (r48 & 15) * 8, tok = t0 + c, col = part * 512 + h * 128 + ch8;
#pragma unroll
        for (int j = 0; j < 4; ++j) { const int tt = tok + j - 2; const bool ok = tt >= 0 && tt < Lseq; xr[i][j] = *(const u32x4_t*)(P + (size_t)(seq0 + (ok ? tt : tok)) * PROJW + col); } }
#pragma unroll
    for (int i = 0; i < 6; ++i) { const int id = tid + 512 * i, c = id / 48, r48 = id - c * 48, part = r48 >> 4, ch8 = (r48 & 15) * 8, tok = t0 + c, col = part * 512 + h * 128 + ch8;
        float acc[8];
#pragma unroll
        for (int e = 0; e < 8; ++e) acc[e] = 0.f;
#pragma unroll
        for (int j = 0; j < 4; ++j) { const int tt = tok + j - 2; const float vm = (tt >= 0 && tt < Lseq) ? 1.0f : 0.0f; float x[8]; unpack8(xr[i][j], x);
            const f32x4_t w0 = *(const f32x4_t*)(conv + j * 1536 + col) * vm, w1 = *(const f32x4_t*)(conv + j * 1536 + col + 4) * vm;
            acc[0] += x[0] * w0.x; acc[1] += x[1] * w0.y; acc[2] += x[2] * w0.z; acc[3] += x[3] * w0.w; acc[4] += x[4] * w1.x; acc[5] += x[5] * w1.y; acc[6] += x[6] * w1.z; acc[7] += x[7] * w1.w; }
        LAS float* dst = part == 0 ? R3 + c * 128 + ch8 : (part == 1 ? kf : vf) + c * 132 + ch8;
        *(LAS f32x4_t*)dst = (f32x4_t){silu(acc[0]), silu(acc[1]), silu(acc[2]), silu(acc[3])}; *(LAS f32x4_t*)(dst + 4) = (f32x4_t){silu(acc[4]), silu(acc[5]), silu(acc[6]), silu(acc[7])}; }
    if (wave < 2) {
        const int d = wave; const size_t row = (size_t)(seq0 + t0 + (d ? 63 - lane : lane));
        const float av = AB[row * 16 + d * 4 + h] + dt_bias[d * 4 + h], bv = AB[row * 16 + 8 + d * 4 + h];
        float g = -__expf(a_log[d * 4 + h]) * (fmaxf(av, 0.f) + __logf(1.0f + __expf(-fabsf(av)))); const float beta = 1.0f / (1.0f + __expf(-bv));
#pragma unroll
        for (int o = 1; o < 64; o <<= 1) { const float t = lane_get(g, (lane - o) & 63); if (lane >= o) g += t; }
        const float glast = lane_get(g, 63);
        LAS float* s = sm + d * 256; s[lane] = g; s[64 + lane] = beta; s[128 + lane] = __expf(g); s[192 + lane] = __expf(glast - g);
        if (lane == 0) *(float*)((d ? blk1 : blk0) + GBLK_GL) = __expf(glast);
    }
    __syncthreads();
    { const int c = tid >> 3, part = (tid >> 2) & 1, q4 = tid & 3; LAS float* rowp = part ? kf + c * 132 + 32 * q4 : R3 + c * 128 + 32 * q4; float ss = 0.f; f32x4_t v[8];
#pragma unroll
      for (int e = 0; e < 8; ++e) { v[e] = *(const LAS f32x4_t*)(rowp + 4 * e); ss += (v[e].x * v[e].x + v[e].y * v[e].y) + (v[e].z * v[e].z + v[e].w * v[e].w); }
      ss += lane_get(ss, lane ^ 1); ss += lane_get(ss, lane ^ 2);
      const float r = rsqrtf(ss + EPS) * (part ? 1.0f : 0.08838834764831845f);
      LAS unsigned char* img = R2 + (part ? 0 : 16384);
#pragma unroll
      for (int e = 0; e < 8; ++e) v[e] = v[e] * r;
      if (part) {
#pragma unroll
          for (int e = 0; e < 8; ++e) *(LAS f32x4_t*)(rowp + 4 * e) = v[e]; }
#pragma unroll
      for (int e2 = 0; e2 < 4; ++e2) { const int col = 32 * q4 + 8 * e2; u32x4_t w; w.x = pk2(v[2 * e2].x, v[2 * e2].y); w.y = pk2(v[2 * e2].z, v[2 * e2].w); w.z = pk2(v[2 * e2 + 1].x, v[2 * e2 + 1].y); w.w = pk2(v[2 * e2 + 1].z, v[2 * e2 + 1].w);
          *(LAS u32x4_t*)(img + img_byte(c + 64 * (col >> 6), col & 63)) = w; } }
    __syncthreads();
    f32x4_t kk[2], qk[2];
    { const int aoff = img_byte(fr, fq * 8), it = wave >> 1, jt0 = 2 * (wave & 1);
      kk[0] = kk[1] = qk[0] = qk[1] = (f32x4_t){0.f, 0.f, 0.f, 0.f};
#pragma unroll
      for (int ks = 0; ks < 4; ++ks) { const int ko = 4 * (ks >> 1) * 2048 + (ks & 1) * 1024;
          const bf16x8_t xk = *(const LAS bf16x8_t*)(R2 + aoff + it * 2048 + ko), xq = *(const LAS bf16x8_t*)(R2 + 16384 + aoff + it * 2048 + ko);
#pragma unroll
          for (int jj = 0; jj < 2; ++jj) { const bf16x8_t yk = *(const LAS bf16x8_t*)(R2 + aoff + (jt0 + jj) * 2048 + ko);
              kk[jj] = __builtin_amdgcn_mfma_f32_16x16x32_bf16(xk, yk, kk[jj], 0, 0, 0); qk[jj] = __builtin_amdgcn_mfma_f32_16x16x32_bf16(xq, yk, qk[jj], 0, 0, 0); } } }
#pragma unroll
    for (int i = 0; i < 4; ++i) { const int id = tid + 512 * i, d = id >> 10, r = id & 1023, c = r >> 4, p8 = r & 15, ks = p8 >> 2, fq2 = p8 & 3, tc = d ? 63 - c : c; const float e = sm[d * 256 + 128 + c];
        const int dk0 = 32 * ks + 4 * fq2, dk1 = dk0 + 16;
        const unsigned long long a = *(const LAS unsigned long long*)(R2 + 16384 + img_byte(tc + 64 * (dk0 >> 6), dk0 & 63)), bq = *(const LAS unsigned long long*)(R2 + 16384 + img_byte(tc + 64 * (dk1 >> 6), dk1 & 63));
        u32x4_t w; w.x = pk2(__uint_as_float((unsigned)a << 16) * e, __uint_as_float((unsigned)a & 0xffff0000u) * e); w.y = pk2(__uint_as_float((unsigned)(a >> 32) << 16) * e, __uint_as_float((unsigned)(a >> 32) & 0xffff0000u) * e);
        w.z = pk2(__uint_as_float((unsigned)bq << 16) * e, __uint_as_float((unsigned)bq & 0xffff0000u) * e); w.w = pk2(__uint_as_float((unsigned)(bq >> 32) << 16) * e, __uint_as_float((unsigned)(bq >> 32) & 0xffff0000u) * e);
        const int pos = 8 * p8; *(u32x4_t*)((d ? blk1 : blk0) + GBLK_Q + img_byte(c + 64 * (pos >> 6), pos & 63)) = w; }
#pragma unroll
    for (int i = 0; i < 4; ++i) { const int id = tid + 512 * i, d = id >> 10, r = id & 1023, dk = r & 127, p8 = r >> 7, grp = p8 >> 2, fq2 = p8 & 3; float v[8];
#pragma unroll
        for (int e = 0; e < 8; ++e) { const int c = 32 * grp + 16 * (e >> 2) + 4 * fq2 + (e & 3), tc = d ? 63 - c : c; v[e] = kf[tc * 132 + dk] * sm[d * 256 + 192 + c]; }
        u32x4_t w; w.x = pk2(v[0], v[1]); w.y = pk2(v[2], v[3]); w.z = pk2(v[4], v[5]); w.w = pk2(v[6], v[7]);
        *(u32x4_t*)((d ? blk1 : blk0) + GBLK_K + img_byte(dk, 8 * p8)) = w; }
    __syncthreads();
    { const int it = wave >> 1, jt0 = 2 * (wave & 1); LAS float* KKs = (LAS float*)R2; LAS float* QKs = KKs + 4096;
#pragma unroll
      for (int jj = 0; jj < 2; ++jj)
#pragma unroll
          for (int e = 0; e < 4; ++e) { const int i = 16 * it + 4 * fq + e, j = 16 * (jt0 + jj) + fr; KKs[i * 64 + j] = kk[jj][e]; QKs[i * 64 + j] = qk[jj][e]; } }
    __syncthreads();
    { const LAS float* KKs = (const LAS float*)R2; const LAS float* QKs = KKs + 4096;
#pragma unroll
      for (int i = 0; i < 4; ++i) { const int id = tid + 512 * i, d = id >> 10, r = id & 1023, c = r >> 4, j0 = 4 * (r & 15), tc = d ? 63 - c : c; const LAS float* s = sm + d * 256; const float gcc = s[c], bc = s[64 + c];
          float lv[4], av[4];
#pragma unroll
          for (int e = 0; e < 4; ++e) { const int j = j0 + e, tj = d ? 63 - j : j; const float dec = __expf(fminf(gcc - s[j], 0.f));
              lv[e] = c > j ? bc * KKs[tc * 64 + tj] * dec : 0.f; av[e] = c >= j ? QKs[tc * 64 + tj] * dec : 0.f; }
          *(LAS f32x4_t*)(R3 + d * 4096 + c * 64 + j0) = (f32x4_t){lv[0], lv[1], lv[2], lv[3]};
          *(unsigned long long*)((d ? blk1 : blk0) + GBLK_A + img_byte(c, posinv(j0))) = (unsigned long long)pk2(av[0], av[1]) | ((unsigned long long)pk2(av[2], av[3]) << 32); } }
    __syncthreads();
    const int d = wave >> 2, w4 = wave & 3, colu = (w4 & 1) * 64 + lane; const LAS float* smd = sm + d * 256; const LAS float* Lm = R3 + d * 4096;
    float U[64];
#pragma unroll
    for (int c = 0; c < 64; ++c) { const int tc = d ? 63 - c : c; U[c] = w4 < 2 ? smd[64 + c] * vf[tc * 132 + colu] : smd[64 + c] * smd[128 + c] * kf[tc * 132 + colu]; }
    __syncthreads();
#pragma unroll
    for (int c = 1; c < 64; ++c) {
        f32x4_t l4[16];
#pragma unroll
        for (int j4 = 0; j4 < (c + 3) / 4; ++j4) l4[j4] = *(const LAS f32x4_t*)(Lm + c * 64 + 4 * j4);
        __builtin_amdgcn_sched_barrier(0);
        float acc = U[c], acc2 = 0.f;
#pragma unroll
        for (int j4 = 0; j4 < (c + 3) / 4; ++j4) {
            acc -= l4[j4].x * U[4 * j4]; if (4 * j4 + 1 < c) acc2 -= l4[j4].y * U[4 * j4 + 1]; if (4 * j4 + 2 < c) acc -= l4[j4].z * U[4 * j4 + 2]; if (4 * j4 + 3 < c) acc2 -= l4[j4].w * U[4 * j4 + 3]; }
        U[c] = acc + acc2;
        __builtin_amdgcn_sched_barrier(0); }
    unsigned char* blk = d ? blk1 : blk0;
    LAS unsigned short* wimg = (LAS unsigned short*)((LAS unsigned char*)vf + d * 16384);
    if (w4 < 2) {
        const int ds = colu >> 4, f16 = colu & 15; float* ub = (float*)(blk + GBLK_U);
#pragma unroll
        for (int c4 = 0; c4 < 16; ++c4) { const int ct = c4 >> 2, fq2 = c4 & 3; *(f32x4_t*)(ub + ((ds * 4 + ct) * 64 + fq2 * 16 + f16) * 4) = (f32x4_t){U[4 * c4], U[4 * c4 + 1], U[4 * c4 + 2], U[4 * c4 + 3]}; }
    } else {
        const int pos = posinv(colu), rofs = 64 * (pos >> 6), col = pos & 63;
#pragma unroll
        for (int c = 0; c < 64; ++c) wimg[img_byte(c + rofs, col) >> 1] = (unsigned short)f2bf(-U[c]);
    }
    __syncthreads();
#pragma unroll
    for (int i = 0; i < 4; ++i) { const int o = (tid + 512 * i) * 16, dd = o >> 14, oo = o & 16383; *(u32x4_t*)((dd ? blk1 : blk0) + GBLK_W + oo) = *(const LAS u32x4_t*)((LAS unsigned char*)vf + o); }
}

__device__ __forceinline__ void gdn_scan_chain(int chain, const unsigned char* __restrict__ gblk, float* __restrict__ OF, float* __restrict__ OB, const float* __restrict__ state_in, float* __restrict__ state_out,
                                               int layer, LAS unsigned char* lds, int tid) {
    const int lane = tid & 63, wave = __builtin_amdgcn_readfirstlane(tid >> 6), fr = lane & 15, fq = lane >> 4, dv = wave * 16 + fr;
    int b, dir, h, seq0, NC, blk0; bool lat;
    if (chain < 128) { lat = false; b = chain >> 3; dir = (chain >> 2) & 1; h = chain & 3; seq0 = b * 256; NC = 4; blk0 = chain * 4; }
    else { const int c2 = chain - 128; lat = true; b = c2 >> 3; dir = (c2 >> 2) & 1; h = c2 & 3; seq0 = MCTX + b * 4096; NC = 64; blk0 = 512 + c2 * 64; }
    const int L = NC * 64;
    f32x4_t S[8];
    const size_t sbase = ((((size_t)b * 2 + layer) * 2 + dir) * 4 + h) * 16384;
    if (lat) {
#pragma unroll
        for (int dt = 0; dt < 8; ++dt)
#pragma unroll
            for (int e = 0; e < 4; ++e) S[dt][e] = state_in[sbase + (size_t)(16 * dt + 4 * fq + e) * 128 + dv]; }
    else {
#pragma unroll
        for (int dt = 0; dt < 8; ++dt) S[dt] = (f32x4_t){0.f, 0.f, 0.f, 0.f}; }
    float* O = dir ? OB : OF;
    const int aoff = img_byte(fr, fq * 8);
    __syncthreads();
    { const unsigned char* src = gblk + (size_t)blk0 * GBLK_BYTES + wave * 1024 + lane * 16;
#pragma unroll
      for (int i = 0; i < 7; ++i) __builtin_amdgcn_global_load_lds((const unsigned*)(src + i * 8192), (LAS unsigned*)(lds + i * 8192 + wave * 1024), 16, 0, 0); }
    f32x4_t ucur[4], unext[4];
    { const float* ub = (const float*)(gblk + (size_t)blk0 * GBLK_BYTES + GBLK_U);
#pragma unroll
      for (int ct = 0; ct < 4; ++ct) ucur[ct] = *(const f32x4_t*)(ub + ((wave * 4 + ct) * 64 + lane) * 4); }
    for (int n = 0; n < NC; ++n) {
        asm volatile("s_waitcnt vmcnt(0)" ::: "memory");
        __builtin_amdgcn_s_barrier();
        asm volatile("" ::: "memory");
        const unsigned char* cblk = gblk + (size_t)(blk0 + n) * GBLK_BYTES;
        LAS unsigned char* buf = lds + (n & 1) * GBLK_DMA;
        if (n + 1 < NC) {
            const unsigned char* src = cblk + GBLK_BYTES + wave * 1024 + lane * 16; LAS unsigned char* nb = lds + ((n + 1) & 1) * GBLK_DMA;
#pragma unroll
            for (int i = 0; i < 7; ++i) __builtin_amdgcn_global_load_lds((const unsigned*)(src + i * 8192), (LAS unsigned*)(nb + i * 8192 + wave * 1024), 16, 0, 0);
            const float* ub = (const float*)(cblk + GBLK_BYTES + GBLK_U);
#pragma unroll
            for (int ct = 0; ct < 4; ++ct) unext[ct] = *(const f32x4_t*)(ub + ((wave * 4 + ct) * 64 + lane) * 4);
        }
        const float gl = *(const float*)(cblk + GBLK_GL);
        bf16x8_t Ys[4];
#pragma unroll
        for (int ks = 0; ks < 4; ++ks) Ys[ks] = pack8(S[2 * ks], S[2 * ks + 1]);
        f32x4_t av[4], ao[4];
#pragma unroll
        for (int ct = 0; ct < 4; ++ct) { av[ct] = ucur[ct]; ao[ct] = (f32x4_t){0.f, 0.f, 0.f, 0.f}; }
#pragma unroll
        for (int ct = 0; ct < 4; ++ct)
#pragma unroll
            for (int ks = 0; ks < 4; ++ks) { const int o = aoff + (ct + 4 * (ks >> 1)) * 2048 + (ks & 1) * 1024;
                const bf16x8_t xw = *(const LAS bf16x8_t*)(buf + GBLK_W + o), xq = *(const LAS bf16x8_t*)(buf + GBLK_Q + o);
                av[ct] = __builtin_amdgcn_mfma_f32_16x16x32_bf16(xw, Ys[ks], av[ct], 0, 0, 0);
                ao[ct] = __builtin_amdgcn_mfma_f32_16x16x32_bf16(xq, Ys[ks], ao[ct], 0, 0, 0); }
        bf16x8_t Yv[2];
#pragma unroll
        for (int ks = 0; ks < 2; ++ks) Yv[ks] = pack8(av[2 * ks], av[2 * ks + 1]);
#pragma unroll
        for (int ct = 0; ct < 4; ++ct)
#pragma unroll
            for (int ks = 0; ks < 2; ++ks) { const bf16x8_t xa = *(const LAS bf16x8_t*)(buf + GBLK_A + aoff + ct * 2048 + ks * 1024);
                ao[ct] = __builtin_amdgcn_mfma_f32_16x16x32_bf16(xa, Yv[ks], ao[ct], 0, 0, 0); }
#pragma unroll
        for (int dt = 0; dt < 8; ++dt) { S[dt] = S[dt] * gl;
#pragma unroll
            for (int ks = 0; ks < 2; ++ks) { const bf16x8_t xk = *(const LAS bf16x8_t*)(buf + GBLK_K + aoff + dt * 2048 + ks * 1024);
                S[dt] = __builtin_amdgcn_mfma_f32_16x16x32_bf16(xk, Yv[ks], S[dt], 0, 0, 0); } }
#pragma unroll
        for (int ct = 0; ct < 4; ++ct)
#pragma unroll
            for (int e = 0; e < 4; ++e) { const int s = n * 64 + 16 * ct + 4 * fq + e, t = dir ? L - 1 - s : s; O[(size_t)(seq0 + t) * 512 + h * 128 + dv] = ao[ct][e]; }
#pragma unroll
        for (int ct = 0; ct < 4; ++ct) ucur[ct] = unext[ct];
    }
    if (!lat) {
#pragma unroll
        for (int dt = 0; dt < 8; ++dt)
#pragma unroll
            for (int e = 0; e < 4; ++e) state_out[sbase + (size_t)(16 * dt + 4 * fq + e) * 128 + dv] = S[dt][e]; }
    asm volatile("s_waitcnt vmcnt(0)" ::: "memory");
    __syncthreads();
}
__device__ __forceinline__ float xrow_max(float x) {
    auto s = __builtin_amdgcn_permlane16_swap(__float_as_uint(x), __float_as_uint(x), false, false); x = fmaxf(__uint_as_float(s[0]), __uint_as_float(s[1]));
    auto t = __builtin_amdgcn_permlane32_swap(__float_as_uint(x), __float_as_uint(x), false, false); return fmaxf(__uint_as_float(t[0]), __uint_as_float(t[1])); }
__device__ __forceinline__ void attn_stage_rc(int bb, int& R, int& C) { const int st = bb / 1024, sb = bb % 1024, swz = sb ^ (((sb >> 9) & 1) << 5); R = (st >> 1) * 16 + swz / 64; C = (st & 1) * 32 + (swz % 64) / 2; }
#ifndef ATT_FIXTHR
#define ATT_FIXTHR 8.0f
#endif
__device__ __forceinline__ void attn_unit(const bf16_t* __restrict__ Q, int ldq, const bf16_t* __restrict__ K, int ldk, const bf16_t* __restrict__ VT, int ldv, int NJ,
                                          const float* __restrict__ lamp, const float* __restrict__ dnorm, bf16_t* __restrict__ CATrow0, LAS unsigned char* lds, int tid, float* __restrict__ part) {
    const int lane = tid & 63, wave = __builtin_amdgcn_readfirstlane(tid >> 6), fr = lane & 15, fq = lane >> 4, comp = wave >> 2, wq = wave & 3;
    const float SC = 0.18033688011112042f;
    const float FIXTHR = ATT_FIXTHR;
    unsigned voffK, voffV[2];
    { int R, C; attn_stage_rc(tid * 16, R, C); voffK = (unsigned)(R * ldk + C) * 2u; voffV[0] = (unsigned)(R * ldv + C) * 2u; attn_stage_rc(tid * 16 + 8192, R, C); voffV[1] = (unsigned)(R * ldv + C) * 2u; }
    const int aoff = img_byte(fr, fq * 8);
    bf16x8_t Qf[2]; u32x4_t qraw[2];
#pragma unroll
    for (int ks = 0; ks < 2; ++ks) qraw[ks] = *(const u32x4_t*)(Q + (size_t)(16 * wq + fr) * ldq + comp * 64 + 32 * ks + 8 * fq);
#define ATT_QCONV() _Pragma("unroll") for (int ks = 0; ks < 2; ++ks) { float qf8[8]; unpack8(qraw[ks], qf8);     \
        u32x4_t w; w.x = cvt2(qf8[0] * SC, qf8[1] * SC); w.y = cvt2(qf8[2] * SC, qf8[3] * SC); w.z = cvt2(qf8[4] * SC, qf8[5] * SC); w.w = cvt2(qf8[6] * SC, qf8[7] * SC); Qf[ks] = __builtin_bit_cast(bf16x8_t, w); }
    f32x4_t O[8];
#pragma unroll
    for (int dt = 0; dt < 8; ++dt) O[dt] = (f32x4_t){0.f, 0.f, 0.f, 0.f};
    float m; f32x4_t Lacc = (f32x4_t){0.f, 0.f, 0.f, 0.f};
    const bf16x8_t ones8_ = (bf16x8_t){0x3F80, 0x3F80, 0x3F80, 0x3F80, 0x3F80, 0x3F80, 0x3F80, 0x3F80};
    __syncthreads();
#define ATT_STAGE(jb, kslot, vslot) do { LAS unsigned char* kl_ = lds + (kslot) * 16384 + wave * 1024; LAS unsigned char* vl_ = lds + 49152 + (vslot) * 16384 + wave * 1024; \
        const char* kp_ = (const char*)K + (size_t)(jb) * 64 * ldk * 2; const char* vp_ = (const char*)VT + (size_t)(jb) * 128; \
        __builtin_amdgcn_global_load_lds((const unsigned*)(kp_ + voffK), (LAS unsigned*)kl_, 16, 0, 0); \
        __builtin_amdgcn_global_load_lds((const unsigned*)(kp_ + 128 + voffK), (LAS unsigned*)(kl_ + 8192), 16, 0, 0); \
        __builtin_amdgcn_global_load_lds((const unsigned*)(vp_ + voffV[0]), (LAS unsigned*)vl_, 16, 0, 0); \
        __builtin_amdgcn_global_load_lds((const unsigned*)(vp_ + voffV[1]), (LAS unsigned*)(vl_ + 8192), 16, 0, 0); } while (0)
    ATT_STAGE(0, 0, 0); ATT_STAGE(1, 1, 1); ATT_STAGE(2, 2, 2);
    __builtin_amdgcn_sched_barrier(0);
    ATT_QCONV();
#undef ATT_QCONV
    asm volatile("s_waitcnt vmcnt(8)" ::: "memory");
    __builtin_amdgcn_s_barrier();
    asm volatile("" ::: "memory");
    f32x4_t S[4], Sn[4];
    bf16x8_t Yp[2] = {(bf16x8_t){0, 0, 0, 0, 0, 0, 0, 0}, (bf16x8_t){0, 0, 0, 0, 0, 0, 0, 0}};
    { const LAS unsigned char* ks_ = lds + comp * 8192 + aoff;
#pragma unroll
      for (int kt = 0; kt < 4; ++kt) { S[kt] = (f32x4_t){0.f, 0.f, 0.f, 0.f};
#pragma unroll
          for (int ks = 0; ks < 2; ++ks) S[kt] = __builtin_amdgcn_mfma_f32_16x16x32_bf16(*(const LAS bf16x8_t*)(ks_ + kt * 2048 + ks * 1024), Qf[ks], S[kt], 0, 0, 0); }
      float mx0 = fmaxf(fmaxf(fmaxf(fmaxf(S[0].x, S[0].y), fmaxf(S[0].z, S[0].w)), fmaxf(fmaxf(S[1].x, S[1].y), fmaxf(S[1].z, S[1].w))), fmaxf(fmaxf(fmaxf(S[2].x, S[2].y), fmaxf(S[2].z, S[2].w)), fmaxf(fmaxf(S[3].x, S[3].y), fmaxf(S[3].z, S[3].w))));
      m = xrow_max(mx0);
#pragma unroll
      for (int kt = 0; kt < 4; ++kt) S[kt] = S[kt] - m; }
    int vm1 = 0  , vj = 0  , vp3 = 3  ;
    for (int j = 0; j < NJ; ++j) {
        if (j + 2 < NJ) asm volatile("s_waitcnt vmcnt(4)" ::: "memory"); else asm volatile("s_waitcnt vmcnt(0)" ::: "memory");
        __builtin_amdgcn_s_barrier();
        asm volatile("" ::: "memory");
        if (j + 3 < NJ) ATT_STAGE(j + 3, j % 3, vp3);
        __builtin_amdgcn_sched_barrier(0);
        bf16x8_t Yn[2]; float alpha = 1.0f, dfix = 0.f; bool anyfix = false;
        const f32x4_t negm4_ = (f32x4_t){-m, -m, -m, -m};
        const LAS unsigned char* ksl_ = lds + ((j + 1) % 3) * 16384 + comp * 8192 + aoff; const LAS unsigned char* vsl_ = lds + 49152 + vm1 * 16384 + aoff;
#define SB_ __builtin_amdgcn_sched_barrier(0)
        { float mx_; bf16x8_t fA_, fB_, fC_, fD_, fE_, fF_;
          fA_ = *(const LAS bf16x8_t*)(ksl_ + 0); fB_ = *(const LAS bf16x8_t*)(ksl_ + 2048); fC_ = *(const LAS bf16x8_t*)(ksl_ + 4096); fD_ = *(const LAS bf16x8_t*)(ksl_ + 6144); fE_ = *(const LAS bf16x8_t*)(ksl_ + 1024);
          fF_ = *(const LAS bf16x8_t*)(ksl_ + 3072); Sn[0] = __builtin_amdgcn_mfma_f32_16x16x32_bf16(fA_, Qf[0], negm4_, 0, 0, 0); SB_;
          fA_ = *(const LAS bf16x8_t*)(ksl_ + 5120); Sn[1] = __builtin_amdgcn_mfma_f32_16x16x32_bf16(fB_, Qf[0], negm4_, 0, 0, 0); mx_ = fmaxf(fmaxf(fmaxf(S[0].x, S[0].y), fmaxf(S[0].z, S[0].w)), fmaxf(fmaxf(S[1].x, S[1].y), fmaxf(S[1].z, S[1].w))); SB_;
          fB_ = *(const LAS bf16x8_t*)(ksl_ + 7168); Sn[2] = __builtin_amdgcn_mfma_f32_16x16x32_bf16(fC_, Qf[0], negm4_, 0, 0, 0); SB_;
          fC_ = *(const LAS bf16x8_t*)(vsl_ + 0); Sn[3] = __builtin_amdgcn_mfma_f32_16x16x32_bf16(fD_, Qf[0], negm4_, 0, 0, 0); mx_ = fmaxf(mx_, fmaxf(fmaxf(fmaxf(S[2].x, S[2].y), fmaxf(S[2].z, S[2].w)), fmaxf(fmaxf(S[3].x, S[3].y), fmaxf(S[3].z, S[3].w)))); SB_;
          fD_ = *(const LAS bf16x8_t*)(vsl_ + 2048); Sn[0] = __builtin_amdgcn_mfma_f32_16x16x32_bf16(fE_, Qf[1], Sn[0], 0, 0, 0); SB_;
          fE_ = *(const LAS bf16x8_t*)(vsl_ + 4096); Sn[1] = __builtin_amdgcn_mfma_f32_16x16x32_bf16(fF_, Qf[1], Sn[1], 0, 0, 0); mx_ = xrow_max(mx_); anyfix = __any(mx_ > FIXTHR); if (anyfix) { dfix = mx_ > FIXTHR ? mx_ : 0.f; m += dfix; alpha = __builtin_amdgcn_exp2f(-dfix); _Pragma("unroll") for (int kt = 0; kt < 4; ++kt) S[kt] = S[kt] - dfix; } SB_;
          fF_ = *(const LAS bf16x8_t*)(vsl_ + 6144); Sn[2] = __builtin_amdgcn_mfma_f32_16x16x32_bf16(fA_, Qf[1], Sn[2], 0, 0, 0); SB_;
          fA_ = *(const LAS bf16x8_t*)(vsl_ + 8192); Sn[3] = __builtin_amdgcn_mfma_f32_16x16x32_bf16(fB_, Qf[1], Sn[3], 0, 0, 0); SB_;
          fB_ = *(const LAS bf16x8_t*)(vsl_ + 10240); O[0] = __builtin_amdgcn_mfma_f32_16x16x32_bf16(fC_, Yp[0], O[0], 0, 0, 0); S[0].x = __builtin_amdgcn_exp2f(S[0].x); S[0].y = __builtin_amdgcn_exp2f(S[0].y); S[0].z = __builtin_amdgcn_exp2f(S[0].z); S[0].w = __builtin_amdgcn_exp2f(S[0].w); SB_;
          fC_ = *(const LAS bf16x8_t*)(vsl_ + 12288); O[1] = __builtin_amdgcn_mfma_f32_16x16x32_bf16(fD_, Yp[0], O[1], 0, 0, 0); SB_;
          fD_ = *(const LAS bf16x8_t*)(vsl_ + 14336); O[2] = __builtin_amdgcn_mfma_f32_16x16x32_bf16(fE_, Yp[0], O[2], 0, 0, 0); SB_;
          fE_ = *(const LAS bf16x8_t*)(vsl_ + 1024); O[3] = __builtin_amdgcn_mfma_f32_16x16x32_bf16(fF_, Yp[0], O[3], 0, 0, 0); S[1].x = __builtin_amdgcn_exp2f(S[1].x); S[1].y = __builtin_amdgcn_exp2f(S[1].y); S[1].z = __builtin_amdgcn_exp2f(S[1].z); S[1].w = __builtin_amdgcn_exp2f(S[1].w); SB_;
          fF_ = *(const LAS bf16x8_t*)(vsl_ + 3072); O[4] = __builtin_amdgcn_mfma_f32_16x16x32_bf16(fA_, Yp[0], O[4], 0, 0, 0); SB_;
          fA_ = *(const LAS bf16x8_t*)(vsl_ + 5120); O[5] = __builtin_amdgcn_mfma_f32_16x16x32_bf16(fB_, Yp[0], O[5], 0, 0, 0); SB_;
          fB_ = *(const LAS bf16x8_t*)(vsl_ + 7168); O[6] = __builtin_amdgcn_mfma_f32_16x16x32_bf16(fC_, Yp[0], O[6], 0, 0, 0); S[2].x = __builtin_amdgcn_exp2f(S[2].x); S[2].y = __builtin_amdgcn_exp2f(S[2].y); S[2].z = __builtin_amdgcn_exp2f(S[2].z); S[2].w = __builtin_amdgcn_exp2f(S[2].w); SB_;
          fC_ = *(const LAS bf16x8_t*)(vsl_ + 9216); O[7] = __builtin_amdgcn_mfma_f32_16x16x32_bf16(fD_, Yp[0], O[7], 0, 0, 0); SB_;
          Lacc = __builtin_amdgcn_mfma_f32_16x16x32_bf16(ones8_, Yp[0], Lacc, 0, 0, 0); SB_;
          fD_ = *(const LAS bf16x8_t*)(vsl_ + 11264); O[0] = __builtin_amdgcn_mfma_f32_16x16x32_bf16(fE_, Yp[1], O[0], 0, 0, 0); S[3].x = __builtin_amdgcn_exp2f(S[3].x); S[3].y = __builtin_amdgcn_exp2f(S[3].y); S[3].z = __builtin_amdgcn_exp2f(S[3].z); S[3].w = __builtin_amdgcn_exp2f(S[3].w); SB_;
          fE_ = *(const LAS bf16x8_t*)(vsl_ + 13312); O[1] = __builtin_amdgcn_mfma_f32_16x16x32_bf16(fF_, Yp[1], O[1], 0, 0, 0); SB_;
          fF_ = *(const LAS bf16x8_t*)(vsl_ + 15360); O[2] = __builtin_amdgcn_mfma_f32_16x16x32_bf16(fA_, Yp[1], O[2], 0, 0, 0); SB_;
          O[3] = __builtin_amdgcn_mfma_f32_16x16x32_bf16(fB_, Yp[1], O[3], 0, 0, 0); Yn[0] = pack8(S[0], S[1]); Yn[1] = pack8(S[2], S[3]); SB_;
          O[4] = __builtin_amdgcn_mfma_f32_16x16x32_bf16(fC_, Yp[1], O[4], 0, 0, 0); SB_;
          O[5] = __builtin_amdgcn_mfma_f32_16x16x32_bf16(fD_, Yp[1], O[5], 0, 0, 0); SB_;
          O[6] = __builtin_amdgcn_mfma_f32_16x16x32_bf16(fE_, Yp[1], O[6], 0, 0, 0); SB_;
          O[7] = __builtin_amdgcn_mfma_f32_16x16x32_bf16(fF_, Yp[1], O[7], 0, 0, 0); SB_;
          Lacc = __builtin_amdgcn_mfma_f32_16x16x32_bf16(ones8_, Yp[1], Lacc, 0, 0, 0); SB_;
        }
        asm volatile("" : "+v"(Yn[0]), "+v"(Yn[1]));
#undef SB_
        __builtin_amdgcn_sched_barrier(0);
        if (anyfix) {
#pragma unroll
            for (int dt = 0; dt < 8; ++dt) O[dt] = O[dt] * alpha;
            Lacc = Lacc * alpha;
#pragma unroll
            for (int kt = 0; kt < 4; ++kt) Sn[kt] = Sn[kt] - dfix; }
#pragma unroll
        for (int kt = 0; kt < 4; ++kt) S[kt] = Sn[kt];
        Yp[0] = Yn[0]; Yp[1] = Yn[1];
        vm1 = vj; vj = vj == 4 ? 0 : vj + 1; vp3 = vp3 == 4 ? 0 : vp3 + 1;
    }
    { const LAS unsigned char* vs_ = lds + 49152 + vm1 * 16384 + aoff;
#pragma unroll
      for (int jj = 0; jj < 2; ++jj)
#pragma unroll
          for (int dt = 0; dt < 8; ++dt) O[dt] = __builtin_amdgcn_mfma_f32_16x16x32_bf16(*(const LAS bf16x8_t*)(vs_ + dt * 2048 + jj * 1024), Yp[jj], O[dt], 0, 0, 0);
      Lacc = __builtin_amdgcn_mfma_f32_16x16x32_bf16(ones8_, Yp[0], Lacc, 0, 0, 0); Lacc = __builtin_amdgcn_mfma_f32_16x16x32_bf16(ones8_, Yp[1], Lacc, 0, 0, 0); }
#undef ATT_STAGE
    if (part) {
        float* po = part + (size_t)(comp * 64 + 16 * wq + fr) * 128 + 4 * fq;
#pragma unroll
        for (int dt = 0; dt < 8; ++dt) *(f32x4_t*)(po + 16 * dt) = O[dt];
        if (fq == 0) { part[16384 + comp * 64 + 16 * wq + fr] = m; part[16384 + 128 + comp * 64 + 16 * wq + fr] = Lacc.x; }
        return;
    }
    const float lam = lamp[0], lam_init = lamp[1];
    { const float f = (comp ? lam : 1.0f) / Lacc.x;
#pragma unroll
      for (int dt = 0; dt < 8; ++dt) O[dt] = O[dt] * f; }
    __syncthreads();
    LAS float* ex = (LAS float*)lds;
    if (comp == 1) {
#pragma unroll
        for (int dt = 0; dt < 8; ++dt) *(LAS f32x4_t*)(ex + (16 * wq + fr) * 132 + 16 * dt + 4 * fq) = O[dt]; }
    __syncthreads();
    if (comp == 0) { float ss = 0.f;
#pragma unroll
        for (int dt = 0; dt < 8; ++dt) { O[dt] = O[dt] - *(const LAS f32x4_t*)(ex + (16 * wq + fr) * 132 + 16 * dt + 4 * fq);
            ss += (O[dt].x * O[dt].x + O[dt].y * O[dt].y) + (O[dt].z * O[dt].z + O[dt].w * O[dt].w); }
        ss += lane_get(ss, lane ^ 16); ss += lane_get(ss, lane ^ 32);
        const float r = rsqrtf(ss * (1.0f / 128.0f) + EPS) * (1.0f - lam_init);
        bf16_t* orow = CATrow0 + (size_t)(16 * wq + fr) * D;
#pragma unroll
        for (int dt = 0; dt < 8; ++dt) { const f32x4_t g = *(const f32x4_t*)(dnorm + 16 * dt + 4 * fq); const f32x4_t y = O[dt] * r * g;
            *(unsigned long long*)(orow + 16 * dt + 4 * fq) = (unsigned long long)pk2(y.x, y.y) | ((unsigned long long)pk2(y.z, y.w) << 32); }
    }
}
constexpr int PART_STRIDE = 16384 + 256;
__device__ __forceinline__ void attn_merge_row(int row, const float* __restrict__ part, const float* __restrict__ lamp, const float* __restrict__ dnorm, bf16_t* __restrict__ CAT, int lane) {
    const int u = row >> 6, r = row & 63; const float* pa = part + (size_t)(2 * u) * PART_STRIDE; const float* pb = pa + PART_STRIDE;
    float o[2][2];
#pragma unroll
    for (int c = 0; c < 2; ++c) { const float ma = pa[16384 + c * 64 + r], mb = pb[16384 + c * 64 + r], la = pa[16384 + 128 + c * 64 + r], lb = pb[16384 + 128 + c * 64 + r];
        const float mm = fmaxf(ma, mb), wa = __builtin_amdgcn_exp2f(ma - mm), wb = __builtin_amdgcn_exp2f(mb - mm), inv = 1.0f / (la * wa + lb * wb);
#pragma unroll
        for (int q = 0; q < 2; ++q) o[c][q] = (pa[(size_t)(c * 64 + r) * 128 + lane + 64 * q] * wa + pb[(size_t)(c * 64 + r) * 128 + lane + 64 * q] * wb) * inv; }
    const float lam = lamp[0], lam_init = lamp[1];
    const float x0 = o[0][0] - lam * o[1][0], x1 = o[0][1] - lam * o[1][1];
    const float rr = rsqrtf(wave_sum(x0 * x0 + x1 * x1, lane) * (1.0f / 128.0f) + EPS) * (1.0f - lam_init);
    bf16_t* orow = CAT + (size_t)(MCTX + 4096 + row) * D + 512 + 7 * 128;
    orow[lane] = (bf16_t)f2bf(x0 * rr * dnorm[lane]); orow[64 + lane] = (bf16_t)f2bf(x1 * rr * dnorm[64 + lane]);
}
__device__ __forceinline__ void vt_item_bf16(const bf16_t* __restrict__ Vsrc, int ldsrc, bf16_t* __restrict__ VTdst, int ldv, int lane) {
    u32x4_t v[16];
#pragma unroll
    for (int i = 0; i < 16; ++i) v[i] = *(const u32x4_t*)(Vsrc + (size_t)lane * ldsrc + 8 * i);
    const int pos = posinv(lane);
#pragma unroll
    for (int i = 0; i < 16; ++i) { const unsigned w[4] = {v[i].x, v[i].y, v[i].z, v[i].w};
#pragma unroll
        for (int j = 0; j < 4; ++j) { VTdst[(size_t)(8 * i + 2 * j) * ldv + pos] = (bf16_t)(w[j] & 0xffffu); VTdst[(size_t)(8 * i + 2 * j + 1) * ldv + pos] = (bf16_t)(w[j] >> 16); } }
}
__device__ __forceinline__ void vt_item_f32(const float* __restrict__ Vsrc, int ldsrc, bf16_t* __restrict__ VTdst, int ldv, int lane) {
    const int pos = posinv(lane);
#pragma unroll
    for (int hb = 0; hb < 2; ++hb) { f32x4_t v[16];
#pragma unroll
        for (int i = 0; i < 16; ++i) v[i] = *(const f32x4_t*)(Vsrc + (size_t)lane * ldsrc + 4 * (16 * hb + i));
#pragma unroll
        for (int i = 0; i < 16; ++i) { const int c = 4 * (16 * hb + i);
            VTdst[(size_t)c * ldv + pos] = (bf16_t)f2bf(v[i].x); VTdst[(size_t)(c + 1) * ldv + pos] = (bf16_t)f2bf(v[i].y); VTdst[(size_t)(c + 2) * ldv + pos] = (bf16_t)f2bf(v[i].z); VTdst[(size_t)(c + 3) * ldv + pos] = (bf16_t)f2bf(v[i].w); } }
}
typedef const __attribute__((address_space(4))) Args* KArgs;
__device__ __forceinline__ KArgs fresh_args() { KArgs k = (KArgs)__builtin_amdgcn_kernarg_segment_ptr(); asm volatile("" : "+s"(k)); return k; }
__device__ __forceinline__ void tail_convert(KArgs ka, LAS unsigned char* lds, int lo, int hi, int idx, int stride, int wave, int lane) {
    LAS float* scr = (LAS float*)(lds + wave * 8448); unsigned char* const W1 = ka->ws + WS_W + W_LAYER;
    for (int d = lo + idx; d < hi; d += stride) {
        const float* src; int ld, Kdst, mode, nblk, r; size_t wofs;
        if (d < DM1) { r = d; src = ka->in[10] + (size_t)D * NFF; ld = NFF; wofs = W_1IN; Kdst = D; mode = 1; nblk = NFF / 32; }
        else if (d < DM2) { r = d - DM1; src = ka->in[11] + (size_t)DFF * D; ld = D; wofs = W_1OUT; Kdst = DFF; mode = 0; nblk = D / 32; }
        else if (d < DM3) { r = d - DM2; src = ka->in[13] + (size_t)D * IN_COLS; ld = IN_COLS; wofs = W_IN; Kdst = D; mode = 2; nblk = NPROJ / 32; }
        else if (d < DM4) { r = d - DM3; src = ka->in[24] + (size_t)D * NFF; ld = NFF; wofs = W_2IN; Kdst = D; mode = 1; nblk = NFF / 32; }
        else if (d < DM5) { r = d - DM4; src = ka->in[22] + (size_t)D * D; ld = D; wofs = W_OUT; Kdst = D; mode = 0; nblk = D / 32; }
        else { r = d - DM5; src = ka->in[25] + (size_t)DFF * D; ld = D; wofs = W_2OUT; Kdst = DFF; mode = 0; nblk = D / 32; }
        tr_item(src, ld, (bf16_t*)(W1 + wofs), Kdst, mode, r, nblk, scr, lane, nullptr, nullptr); }
}
#define PHASE_IDS FRESH_LDS; const int tid = fresh_tid_w(wave_s), lane = tid & 63, wave = __builtin_amdgcn_readfirstlane(tid >> 6), gw = wg * NWAVES + wave; (void)lane; (void)gw; (void)lds
#define PHASE_PTRS KArgs ka = fresh_args(); unsigned char* const ws = ka->ws; float* const out = ka->out; (void)out; \
    float* const ADA = (float*)(ws + WS_ADA); float* const LAM = (float*)(ws + WS_LAM); float* const X = (float*)(ws + WS_X); bf16_t* const H = (bf16_t*)(ws + WS_H); bf16_t* const CAT = (bf16_t*)(ws + WS_CAT); \
    bf16_t* const ACT = (bf16_t*)(ws + WS_ACT); bf16_t* const P = (bf16_t*)(ws + WS_PROJ); float* const AB = (float*)(ws + WS_AB); float* const GQ = (float*)(ws + WS_GQ); float* const GK = (float*)(ws + WS_GK); \
    float* const GV = (float*)(ws + WS_GV); float* const GG = (float*)(ws + WS_GG); float* const GB = (float*)(ws + WS_GB); float* const OF = (float*)(ws + WS_OF); float* const OB = (float*)(ws + WS_OB); \
    bf16_t* const QB = (bf16_t*)(ws + WS_QB); bf16_t* const KB = (bf16_t*)(ws + WS_KB); bf16_t* const VTL = (bf16_t*)(ws + WS_VTL); bf16_t* const VTC = (bf16_t*)(ws + WS_VTC); \
    const unsigned char* const Wl = ws + WS_W + (size_t)l * W_LAYER; const float* const ada = ADA + (size_t)l * 3 * ADA_N; \
    (void)LAM; (void)X; (void)H; (void)CAT; (void)ACT; (void)P; (void)AB; (void)GQ; (void)GK; (void)GV; (void)GG; (void)GB; (void)OF; (void)OB; (void)QB; (void)KB; (void)VTL; (void)VTC; (void)Wl; (void)ada
__global__ void __launch_bounds__(NWAVES * 64, 2) mega_fwd(Args a) {
    extern __shared__ __attribute__((aligned(16))) unsigned char lds_raw[];
    LAS unsigned char* const lds0 = (LAS unsigned char*)lds_raw;
#define FRESH_LDS LAS unsigned char* lds = lds0; asm volatile("" : "+s"(lds))
    const int G = gridDim.x, wg = blockIdx.x, NGW = G * NWAVES, wave_s = __builtin_amdgcn_readfirstlane(threadIdx.x >> 6);
    if (threadIdx.x < 64) ((LAS unsigned*)(lds0 + LDS_MISC))[threadIdx.x] = 0u;
    __syncthreads();
    (void)xcd_barrier_post((unsigned*)(a.ws + WS_CTL) + CW_BAR, (volatile LAS unsigned*)(lds0 + LDS_MISC + 32));
#define GRID_BARRIER() do { FRESH_LDS; KArgs kb_ = fresh_args(); XcdBarrier b_; b_.bar = (unsigned*)(kb_->ws + WS_CTL) + CW_BAR; b_.x = xb_xcc_id(); b_.st = (volatile LAS unsigned*)(lds + LDS_MISC + 32); xcd_barrier(b_, fresh_tid_w(wave_s)); } while (0)

    { PHASE_IDS; KArgs ka = fresh_args(); Ptrs p;
      p.x_prompt = ka->in[0]; p.x_sample = ka->in[1]; p.c = ka->in[2]; p.cache_k = ka->in[3]; p.cache_v = ka->in[4]; p.state_gdn = ka->in[5]; p.c_ctx = ka->in[6]; p.w_ada = ka->in[7]; p.b_ada = ka->in[8];
      p.norm_ffn1 = ka->in[9]; p.ffn1_in = ka->in[10]; p.ffn1_out = ka->in[11]; p.norm_mix = ka->in[12]; p.w_in = ka->in[13]; p.gdn_conv = ka->in[14]; p.gdn_a_log = ka->in[15]; p.gdn_dt_bias = ka->in[16];
      p.gdn_norm = ka->in[17]; p.diff_lam = ka->in[18]; p.diff_norm = ka->in[19]; p.pool_w = ka->in[20]; p.pool_scale = ka->in[21]; p.w_out = ka->in[22]; p.norm_ffn2 = ka->in[23]; p.ffn2_in = ka->in[24];
      p.ffn2_out = ka->in[25]; p.final_norm = ka->in[26];
      ph_prologue(p, ka->ws, lds, gw, NGW, wave, lane, tid); }
    GRID_BARRIER();

    for (int l = 0; l < DEPTH; ++l) {
        { PHASE_IDS; PHASE_PTRS; const float* x_prompt = ka->in[0]; const float* x_sample = ka->in[1]; const float* gain = ka->in[9] + l * D;
          for (int row = gw; row < M; row += NGW) {
            const float* xrow = (l == 0) ? (row < MCTX ? x_prompt + (size_t)row * D : x_sample + (size_t)(row - MCTX) * D) : X + (size_t)row * D;
            norm_row(xrow, row, gain, ada + 0 * D, ada + 1 * D, H, nullptr, lane);
        } }
        GRID_BARRIER();
        { FRESH_LDS; PHASE_PTRS; pg8::Gemm g{H, (const bf16_t*)(Wl + W_1IN), M, NFF, D, 0}; pg8::StaticOrder S; S.init(M, NFF, G, wg); pg8::EpiSwiglu E{ACT, DFF, 0};
          pg8::gemm_phase<pg8::EpiSwiglu, pg8::StaticOrder, true, true>(lds, g, S, E, fresh_tid_w(wave_s)); }
        if (G == 256 && wg >= 128) { __syncthreads(); PHASE_IDS; KArgs ka = fresh_args(); tail_convert(ka, lds, l ? DSEG3 : DSEG0, l ? DSEG4 : DSEG1, (wg - 128) * NWAVES + wave, 128 * NWAVES, wave, lane); }
        GRID_BARRIER();
        { FRESH_LDS; PHASE_PTRS; pg8::Gemm g{ACT, (const bf16_t*)(Wl + W_1OUT), M, D, DFF, 0}; pg8::StaticOrder S; S.init(M, D, G, wg, 192); const float* r0_ = l == 0 ? ka->in[0] : X; const float* r1_ = l == 0 ? ka->in[1] : X + (size_t)4096 * D; pg8::EpiResidTQ E{X, r0_, r1_, ada + 2 * D, D, ADA_N, 0.5f, 0};
          pg8::gemm_phase<pg8::EpiResidTQ, pg8::StaticOrder, true, true, true>(lds, g, S, E, fresh_tid_w(wave_s)); }
        GRID_BARRIER();
        { PHASE_IDS; PHASE_PTRS; const float* gain = ka->in[12] + l * D;
          for (int row = gw; row < M; row += NGW) norm_row(X + (size_t)row * D, row, gain, ada + 3 * D, ada + 4 * D, H, nullptr, lane); }
        GRID_BARRIER();
        { FRESH_LDS; PHASE_PTRS; pg8::Gemm g{H, (const bf16_t*)(Wl + W_IN), M, NPROJ, D, 0}; pg8::StaticOrder S; S.init(M, NPROJ, G, wg);
          pg8::EpiProj E{P, AB};
          pg8::gemm_phase<pg8::EpiProj, pg8::StaticOrder, true, true>(lds, g, S, E, fresh_tid_w(wave_s)); }
        if (G == 256 && wg >= 160) { __syncthreads(); PHASE_IDS; KArgs ka = fresh_args(); tail_convert(ka, lds, l ? DSEG4 : DSEG1, l ? DSEG5 : DSEG2, (wg - 160) * NWAVES + wave, 96 * NWAVES, wave, lane); }
        GRID_BARRIER();
        { PHASE_IDS; PHASE_PTRS; const float* cache_k = ka->in[3]; const float* cache_v = ka->in[4]; const float* conv = ka->in[14] + (size_t)l * 4 * 1536; const float* a_log = ka->in[15] + l * 8; const float* dt_bias = ka->in[16] + l * 8;
          for (int item = wg; item < 768; item += G) gdn_prep_item(item, P, AB, conv, a_log, dt_bias, ws + WS_GBLK, lds, tid);
          __syncthreads();
          LAS float* tab = (LAS float*)lds;
          for (int i = tid; i < 1024; i += NWAVES * 64) { float sn, cs; sincosf((float)(i >> 4) * __expf(-(float)(i & 15) * 0.5756462732485114f), &sn, &cs); tab[2 * i] = cs; tab[2 * i + 1] = sn; }
          __syncthreads();
          for (int row = gw; row < M; row += 2 * NGW) {
              const int rA = row, rB = row + NGW; const bool hasB = rB < M;
              u32x4_t xa[4], ta[16], tb[16];
              if (rA >= MCTX) rope_load(rA - MCTX, P, lane, xa);
              else {
#pragma unroll
                  for (int i = 0; i < 2; ++i) { xa[2 * i] = *(const u32x4_t*)(P + (size_t)rA * PROJW + 3072 + 8 * (lane + 64 * i)); xa[2 * i + 1] = *(const u32x4_t*)(P + (size_t)rA * PROJW + 4096 + 8 * (lane + 64 * i)); } }
              pool_load(rA, P, lane, ta); pool_load(hasB ? rB : rA, P, lane, tb);
              __builtin_amdgcn_sched_barrier(0);
              pool_finish(rA, ta, CAT, lane);
              __builtin_amdgcn_sched_barrier(0);
#pragma unroll
              for (int q = 0; q < 2; ++q) { const int rr = q ? rB : rA; if (q && !hasB) break;
                  if (q) { if (rr >= MCTX) rope_load(rr - MCTX, P, lane, xa);
                      else {
#pragma unroll
                          for (int i = 0; i < 2; ++i) { xa[2 * i] = *(const u32x4_t*)(P + (size_t)rr * PROJW + 3072 + 8 * (lane + 64 * i)); xa[2 * i + 1] = *(const u32x4_t*)(P + (size_t)rr * PROJW + 4096 + 8 * (lane + 64 * i)); } }
                      pool_finish(rB, tb, CAT, lane); __builtin_amdgcn_sched_barrier(0); }
                  if (rr >= MCTX) rope_finish(rr - MCTX, xa, QB, KB, tab, lane);
                  else { float* ck = out + OUT_CK + (((size_t)(rr >> 8) * 2 + l) * 256 + (rr & 255)) * 1024; float* cv = out + OUT_CV + (((size_t)(rr >> 8) * 2 + l) * 256 + (rr & 255)) * 1024;
#pragma unroll
                      for (int i = 0; i < 2; ++i) { float fk[8], fv[8]; unpack8(xa[2 * i], fk); unpack8(xa[2 * i + 1], fv);
                          *(f32x4_t*)(ck + 8 * (lane + 64 * i)) = (f32x4_t){fk[0], fk[1], fk[2], fk[3]}; *(f32x4_t*)(ck + 8 * (lane + 64 * i) + 4) = (f32x4_t){fk[4], fk[5], fk[6], fk[7]};
                          *(f32x4_t*)(cv + 8 * (lane + 64 * i)) = (f32x4_t){fv[0], fv[1], fv[2], fv[3]}; *(f32x4_t*)(cv + 8 * (lane + 64 * i) + 4) = (f32x4_t){fv[4], fv[5], fv[6], fv[7]}; } }
                  __builtin_amdgcn_sched_barrier(0); }
          }
          for (int row = M + gw; row < M + 2 * PAST + 1664; row += NGW) {
            if (false) {
            } else if (row < M + 2 * PAST) {
                const int r = row - M, b = r >> 9, kk = r & 511; const size_t sidx = (((size_t)b * DEPTH + l) * PAST + kk) * 1024, d = ((size_t)b * LK_LAT + kk) * 1024;
#pragma unroll
                for (int i = 0; i < 2; ++i) { const f32x4_t v0 = *(const f32x4_t*)(cache_k + sidx + 8 * (lane + 64 * i)), v1 = *(const f32x4_t*)(cache_k + sidx + 8 * (lane + 64 * i) + 4);
                    u32x4_t w; w.x = pk2(v0.x, v0.y); w.y = pk2(v0.z, v0.w); w.z = pk2(v1.x, v1.y); w.w = pk2(v1.z, v1.w); *(u32x4_t*)(KB + d + 8 * (lane + 64 * i)) = w; }
            } else {
                const int it = row - (M + 2 * PAST);
                if (it < 1152) { const int b = it / 576, r2 = it - b * 576, h = r2 / 72, kblk = r2 - h * 72; bf16_t* dst = VTL + ((size_t)(b * 8 + h) * 128) * LK_LAT + 64 * kblk;
                    if (kblk < 8) vt_item_f32(cache_v + (((size_t)b * DEPTH + l) * PAST + 64 * kblk) * 1024 + h * 128, 1024, dst, LK_LAT, lane);
                    else vt_item_bf16(P + (size_t)(MCTX + b * 4096 + 64 * (kblk - 8)) * PROJW + 4096 + h * 128, PROJW, dst, LK_LAT, lane); }
                else { const int i2 = it - 1152, b = i2 >> 5, h = (i2 >> 2) & 7, kblk = i2 & 3;
                    vt_item_bf16(P + (size_t)(b * 256 + 64 * kblk) * PROJW + 4096 + h * 128, PROJW, VTC + ((size_t)(b * 8 + h) * 128) * 256 + 64 * kblk, 256, lane); }
            }
          } }
        GRID_BARRIER();
        { PHASE_IDS; PHASE_PTRS; const float* state_gdn = ka->in[5];
          for (int ci = wg; ci < 144; ci += G) gdn_scan_chain(ci < 16 ? 128 + ci : ci - 16, ws + WS_GBLK, OF, OB, state_gdn, out + OUT_ST, l, lds, tid); }
        { PHASE_IDS; PHASE_PTRS; const float* dnorm = ka->in[19] + l * 128; unsigned* qhead = (unsigned*)(ws + WS_CTL) + CW_QUEUE + 64 * l; LAS unsigned* qslot = (LAS unsigned*)(lds + LDS_MISC + 64);
          bool lat_open = wg >= 16 || G < 32;
          for (;;) {
            __syncthreads();
            if (tid == 0) { unsigned it = 0xffffffffu; if (lat_open) { it = atomicAdd(qhead, 1u); if (it >= 1088u) it = 0xffffffffu; } if (it == 0xffffffffu) { it = atomicAdd(qhead + 128, 1u); it = it < 512u ? it + 1088u : 0xffffffffu; } *qslot = it; }
            __syncthreads();
            const unsigned item = *qslot;
            if (item >= 1600u) break;
            if (item >= 1088u) lat_open = false;
            const bf16_t *aQ, *aK, *aV; int ldq, ldk, ldv, nb, qrow0, hh; float* part = nullptr;
            if (item < 1088u) { const unsigned fu = item < 960u ? item : 960u + ((item - 960u) >> 1); const int kh = item < 960u ? -1 : (int)((item - 960u) & 1u);
                const int b = fu >> 9, h = (fu >> 6) & 7, qb = fu & 63; qrow0 = MCTX + b * 4096 + 64 * qb; hh = h;
                aQ = QB + (size_t)(b * 4096 + 64 * qb) * 1024 + h * 128; ldq = 1024; aK = KB + (size_t)b * LK_LAT * 1024 + h * 128; ldk = 1024; aV = VTL + ((size_t)(b * 8 + h) * 128) * LK_LAT; ldv = LK_LAT; nb = LK_LAT / 64;
                if (kh >= 0) { nb = LK_LAT / 128; aK += (size_t)kh * (LK_LAT / 2) * 1024; aV += (size_t)kh * (LK_LAT / 2); part = (float*)(ws + WS_ACT) + (size_t)((fu - 960u) * 2u + (unsigned)kh) * PART_STRIDE; } }
            else { const int i2 = item - 1088, b = i2 >> 5, h = (i2 >> 2) & 7, qb = i2 & 3; qrow0 = b * 256 + 64 * qb; hh = h;
                aQ = P + (size_t)qrow0 * PROJW + 2048 + h * 128; ldq = PROJW; aK = P + (size_t)(b * 256) * PROJW + 3072 + h * 128; ldk = PROJW; aV = VTC + ((size_t)(b * 8 + h) * 128) * 256; ldv = 256; nb = 4; }
            attn_unit(aQ, ldq, aK, ldk, aV, ldv, nb, LAM + 2 * l, dnorm, CAT + (size_t)qrow0 * D + 512 + hh * 128, lds, tid, part);
        } }
        GRID_BARRIER();
        { PHASE_IDS; PHASE_PTRS; const float* gnorm = ka->in[17] + l * 128;
          for (int row = gw; row < M; row += NGW) gdn_out_row(row, OF, OB, P, gnorm, CAT, lane);
          for (int row = gw; row < 4096; row += NGW) attn_merge_row(row, (const float*)(ws + WS_ACT), LAM + 2 * l, ka->in[19] + l * 128, CAT, lane); }
        GRID_BARRIER();
        { FRESH_LDS; PHASE_PTRS; pg8::Gemm g{CAT, (const bf16_t*)(Wl + W_OUT), M, D, D, 0}; pg8::StaticOrder S; S.init(M, D, G, wg, 192); pg8::EpiResidTQ E{X, X, X + (size_t)4096 * D, ada + 5 * D, D, ADA_N, 1.0f, 0};
          pg8::gemm_phase<pg8::EpiResidTQ, pg8::StaticOrder, true, true, true>(lds, g, S, E, fresh_tid_w(wave_s)); }
        GRID_BARRIER();
        { PHASE_IDS; PHASE_PTRS; const float* gain = ka->in[23] + l * D;
          for (int row = gw; row < M; row += NGW) norm_row(X + (size_t)row * D, row, gain, ada + 6 * D, ada + 7 * D, H, nullptr, lane); }
        GRID_BARRIER();
        { FRESH_LDS; PHASE_PTRS; pg8::Gemm g{H, (const bf16_t*)(Wl + W_2IN), M, NFF, D, 0}; pg8::StaticOrder S; S.init(M, NFF, G, wg); pg8::EpiSwiglu E{ACT, DFF, 0};
          pg8::gemm_phase<pg8::EpiSwiglu, pg8::StaticOrder, true, true>(lds, g, S, E, fresh_tid_w(wave_s)); }
        if (G == 256 && wg >= 128) { __syncthreads(); PHASE_IDS; KArgs ka = fresh_args(); tail_convert(ka, lds, l ? DSEG5 : DSEG2, l ? DSEG6 : DSEG3, (wg - 128) * NWAVES + wave, 128 * NWAVES, wave, lane); }
        GRID_BARRIER();
        { FRESH_LDS; PHASE_PTRS; pg8::Gemm g{ACT, (const bf16_t*)(Wl + W_2OUT), M, D, DFF, 0}; pg8::StaticOrder S; S.init(M, D, G, wg, 192); pg8::EpiResidTQ E{X, X, X + (size_t)4096 * D, ada + 8 * D, D, ADA_N, 0.5f, 0};
          pg8::gemm_phase<pg8::EpiResidTQ, pg8::StaticOrder, true, true, true>(lds, g, S, E, fresh_tid_w(wave_s)); }
        GRID_BARRIER();
    }
    { const int l = 0; PHASE_IDS; PHASE_PTRS; const float* gain = ka->in[26];
      for (int row = gw; row < M; row += NGW) final_norm_row(X, row, gain, out, lane); }
}

extern "C" void kernel_launch(void* const* d_in, const int* in_sizes, int n_in, void* d_out, int out_size, void* d_ws, size_t ws_size, hipStream_t stream) {
    static int grid = 0;
    if (grid == 0) {
        if (n_in != 27 || out_size != (int)OUT_TOTAL || ws_size < WS_END) { fprintf(stderr, "kernel_launch: unexpected sizes n_in %d out %d ws %zu\n", n_in, out_size, ws_size); grid = -1; return; }
        int dev = 0, cus = 0, per_cu = 0; (void)hipGetDevice(&dev); (void)hipDeviceGetAttribute(&cus, hipDeviceAttributeMultiprocessorCount, dev);
        if (hipFuncSetAttribute((const void*)mega_fwd, hipFuncAttributeMaxDynamicSharedMemorySize, LDS_BYTES) != hipSuccess) { fprintf(stderr, "kernel_launch: hipFuncSetAttribute failed\n"); grid = -1; return; }
        if (hipOccupancyMaxActiveBlocksPerMultiprocessor(&per_cu, (const void*)mega_fwd, NWAVES * 64, LDS_BYTES) != hipSuccess || per_cu < 1) fprintf(stderr, "kernel_launch: occupancy query says %d\n", per_cu);
        (void)hipGetLastError();
        grid = cus > 0 ? cus : 256;
    }
    if (grid < 0) return;
    (void)hipMemsetAsync((char*)d_ws + WS_CTL, 0, CTL_BYTES + ADA_BYTES, stream);
    Args a{};
    for (int i = 0; i < 27; ++i) a.in[i] = (const float*)d_in[i];
    a.out = (float*)d_out; a.ws = (unsigned char*)d_ws;
    hipLaunchKernelGGL(mega_fwd, dim3(grid), dim3(NWAVES * 64), LDS_BYTES, stream, a);
}
```

```cpp
#include <hip/hip_runtime.h>
#include <cstdio>
#include <cstdint>
namespace pg8 {
#define PG8_LAS __attribute__((address_space(3)))
typedef unsigned short bf16_t;
typedef short bf16x8 __attribute__((ext_vector_type(8)));
typedef float f32x4 __attribute__((ext_vector_type(4)));
typedef unsigned u32x4 __attribute__((ext_vector_type(4)));
constexpr int BM = 256, BK = 64, HALF = 128, HTB = HALF * BK * 2  , STAGE_BYTES = 8 * HTB, NXCD = 8, WGM = 8;

__host__ __device__ __forceinline__ int lds_byte(int r, int c) { const int st = (r >> 4) * 2 + (c >> 5), rr = r & 15, cc = c & 31, ob = rr * 64 + cc * 2; return st * 1024 + (ob ^ (((ob >> 9) & 1) << 5)); }
__host__ __device__ __forceinline__ void stage_rc(int b, int& R, int& C) { const int st = b / 1024, sb = b % 1024, swz = sb ^ (((sb >> 9) & 1) << 5); R = (st >> 1) * 16 + swz / 64; C = (st & 1) * 32 + (swz % 64) / 2; }
__host__ __device__ __forceinline__ int perm32(int rho) { const int n = rho >> 4, i = rho & 15; return 8 * (i >> 2) + 4 * n + (i & 3); }

struct Unit { int pm, pn, half; };
struct Gemm { const bf16_t* A; const bf16_t* Bt; int M, N, K, pad; };

struct StaticOrder {
    int nM, nN, nwg, G, c, nfull, halves;
    __host__ __device__ __forceinline__ void init(int M, int N, int G_, int c_, int bm = BM) { nM = M / bm; nN = N / BM; nwg = nM * nN; G = G_; c = c_; nfull = (nwg / G) * G; const int rem = nwg - nfull; halves = (bm == BM && rem > 0 && 2 * rem <= G) ? 1 : 0; }
    __host__ __device__ __forceinline__ bool next(int i, Unit& u) const {
        long L = (long)i * G + c; u.half = 0;
        if (halves && L >= nfull) { if (L >= nfull + G) return false; L = nfull + (c >> 1); u.half = 1 + (c & 1); }
        if (L >= nwg) return false;
        int wgid = (int)L; { const int q = nwg / NXCD, r = nwg % NXCD, xcd = wgid % NXCD, off = wgid / NXCD; wgid = (xcd < r ? xcd * (q + 1) : r * (q + 1) + (xcd - r) * q) + off; }
        const int nig = WGM * nN, gid = wgid / nig, fm = gid * WGM, gsz = (nM - fm) < WGM ? (nM - fm) : WGM;
        u.pm = fm + ((wgid % nig) % gsz); u.pn = (wgid % nig) / gsz; return true;
    }
    __device__ __forceinline__ void a_ready(const Unit&) const {}
    __device__ __forceinline__ void done(const Unit&) const {}
};
__device__ __forceinline__ unsigned cvt_pk_bf16(float lo, float hi) { unsigned r; asm volatile("v_cvt_pk_bf16_f32 %0, %1, %2" : "=v"(r) : "v"(lo), "v"(hi)); return r; }
typedef float f32x2 __attribute__((ext_vector_type(2)));
__device__ __forceinline__ float silu_f(float x) { return x * __builtin_amdgcn_rcpf(1.0f + __expf(-x)); }
struct EpiSwiglu {
    static constexpr bool PERM = true, AFTER_DRAIN = false;
    bf16_t* O; int ldc, pad;
    __device__ __forceinline__ void operator()(const f32x4 (&acc)[2][2][4][2], const Unit& u, int wr, int wc, int fr, int fq) const {
        const int row0 = u.pm * BM + wr * 64 + fr + (u.half == 2 ? HALF : 0), col0 = u.pn * HALF + wc * 32 + 8 * fq;
#pragma unroll
        for (int ai = 0; ai < 2; ++ai) { if (ai == 1 && u.half) break;
#pragma unroll
            for (int m = 0; m < 4; ++m) { bf16_t* rowp = O + (size_t)(row0 + ai * HALF + m * 16) * ldc + col0;
                float r[8];
#pragma unroll
                for (int n = 0; n < 2; ++n)
#pragma unroll
                    for (int e = 0; e < 4; ++e) r[n * 4 + e] = silu_f(acc[ai][0][m][n][e]) * acc[ai][1][m][n][e];
                u32x4 w; w.x = cvt_pk_bf16(r[0], r[1]); w.y = cvt_pk_bf16(r[2], r[3]); w.z = cvt_pk_bf16(r[4], r[5]); w.w = cvt_pk_bf16(r[6], r[7]);
                *(u32x4*)rowp = w; } }
    }
};
struct EpiResid {
    static constexpr bool PERM = false, AFTER_DRAIN = false;
    float* X; const float* gate; int ldc, cond_stride; float coef; int pad;
    __device__ __forceinline__ void operator()(const f32x4 (&acc)[2][2][4][2], const Unit& u, int wr, int wc, int fr, int fq) const {
        const int row0 = u.pm * BM + wr * 64 + fr + (u.half == 2 ? HALF : 0), col0 = u.pn * BM + wc * 32 + 4 * fq;
        const int cond = u.pm < 16 ? 0 : (u.pm < 32 ? 1 : 2);
        const float* gp = gate + (size_t)cond * cond_stride + col0;
        f32x4 gv[2][2];
#pragma unroll
        for (int bj = 0; bj < 2; ++bj)
#pragma unroll
            for (int n = 0; n < 2; ++n) gv[bj][n] = *(const f32x4*)(gp + bj * HALF + n * 16) * coef;
#pragma unroll
        for (int ai = 0; ai < 2; ++ai) { if (ai == 1 && u.half) break;
#pragma unroll
            for (int m = 0; m < 4; ++m) { float* rowp = X + (size_t)(row0 + ai * HALF + m * 16) * ldc + col0;
#pragma unroll
                for (int bj = 0; bj < 2; ++bj)
#pragma unroll
                    for (int n = 0; n < 2; ++n) { f32x4* p = (f32x4*)(rowp + bj * HALF + n * 16); *p = *p + gv[bj][n] * acc[ai][bj][m][n]; } } }
    }
};
struct EpiResidTQ {
    static constexpr bool PERM = false, AFTER_DRAIN = false;
    float* X; const float* R0; const float* R1; const float* gate; int ldc, cond_stride; float coef; int pad;
    __device__ __forceinline__ void operator()(const f32x4 (&acc)[2][2][4][2], const Unit& u, int wr, int wc, int fr, int fq) const {
        const int rbase = u.pm * 192, col0 = u.pn * BM + wc * 32 + 4 * fq;
        constexpr int AI[6] = {0, 0, 0, 0, 1, 1}, MM[6] = {0, 1, 2, 3, 0, 1};
        int cur_cond; f32x4 gv[2][2];
        { const int rg0 = rbase + wr * 64; cur_cond = rg0 < 4096 ? 0 : (rg0 < 8192 ? 1 : 2); const float* gp = gate + (size_t)cur_cond * cond_stride + col0;
#pragma unroll
          for (int bj = 0; bj < 2; ++bj)
#pragma unroll
              for (int n = 0; n < 2; ++n) gv[bj][n] = *(const f32x4*)(gp + bj * HALF + n * 16) * coef; }
#pragma unroll
        for (int hb = 0; hb < 2; ++hb) {
            f32x4 xin[3][2][2];
#pragma unroll
            for (int q = 0; q < 3; ++q) { const int g = 3 * hb + q, rg = rbase + (AI[g] ? HALF + wr * 32 : wr * 64) + MM[g] * 16; const float* rowp = (rg < 4096 ? R0 + (size_t)(rg + fr) * ldc : R1 + (size_t)(rg + fr - 4096) * ldc) + col0;
#pragma unroll
                for (int bj = 0; bj < 2; ++bj)
#pragma unroll
                    for (int n = 0; n < 2; ++n) xin[q][bj][n] = *(const f32x4*)(rowp + bj * HALF + n * 16); }
#pragma unroll
            for (int q = 0; q < 3; ++q) { const int g = 3 * hb + q, rg = rbase + (AI[g] ? HALF + wr * 32 : wr * 64) + MM[g] * 16, cond = rg < 4096 ? 0 : (rg < 8192 ? 1 : 2);
                if (cond != cur_cond) { cur_cond = cond; const float* gp = gate + (size_t)cond * cond_stride + col0;
#pragma unroll
                    for (int bj = 0; bj < 2; ++bj)
#pragma unroll
                        for (int n = 0; n < 2; ++n) gv[bj][n] = *(const f32x4*)(gp + bj * HALF + n * 16) * coef; }
                float* rowp = X + (size_t)(rg + fr) * ldc + col0;
#pragma unroll
                for (int bj = 0; bj < 2; ++bj)
#pragma unroll
                    for (int n = 0; n < 2; ++n) *(f32x4*)(rowp + bj * HALF + n * 16) = xin[q][bj][n] + gv[bj][n] * acc[AI[g]][bj][MM[g]][n]; }
        }
    }
};
struct EpiProj {
    static constexpr bool PERM = true, AFTER_DRAIN = false;
    bf16_t* P; float* AB;
    __device__ __forceinline__ void operator()(const f32x4 (&acc)[2][2][4][2], const Unit& u, int wr, int wc, int fr, int fq) const {
        const int row0 = u.pm * BM + wr * 64 + fr + (u.half == 2 ? HALF : 0), col0 = u.pn * BM + wc * 32 + 8 * fq;
        if (u.pn < 22) {
            bf16_t* rowp = P + (size_t)row0 * 5632 + col0;
#pragma unroll
            for (int ai = 0; ai < 2; ++ai) { if (ai == 1 && u.half) break;
#pragma unroll
                for (int m = 0; m < 4; ++m) {
#pragma unroll
                    for (int bj = 0; bj < 2; ++bj) { const f32x4 v0 = acc[ai][bj][m][0], v1 = acc[ai][bj][m][1];
                        u32x4 w; w.x = cvt_pk_bf16(v0[0], v0[1]); w.y = cvt_pk_bf16(v0[2], v0[3]); w.z = cvt_pk_bf16(v1[0], v1[1]); w.w = cvt_pk_bf16(v1[2], v1[3]);
                        *(u32x4*)(rowp + bj * HALF) = w; }
                    rowp += (m == 3 ? (HALF - 48) : 16) * 5632; asm volatile("" : "+v"(rowp)); } }
        } else {
            if (wc == 0 && fq < 2) {
#pragma unroll
                for (int ai = 0; ai < 2; ++ai) { if (ai == 1 && u.half) break;
#pragma unroll
                    for (int m = 0; m < 4; ++m) { float* rowp = AB + (size_t)(row0 + ai * HALF + m * 16) * 16 + 8 * fq;
                        *(f32x4*)rowp = acc[ai][0][m][0]; *(f32x4*)(rowp + 4) = acc[ai][0][m][1]; } }
            }
        }
    }
};
template <class Epi, class Sched, bool ALIGN_EPI = false, bool SP2 = false, bool TQ = false>
__device__ __forceinline__ void gemm_phase(PG8_LAS unsigned char* lds, const Gemm g, const Sched& S, const Epi& E, const int tid) {
    const int wid = __builtin_amdgcn_readfirstlane(tid >> 6), lane = tid & 63, wr = wid >> 2, wc = wid & 3, fr = lane & 15, fq = lane >> 4;
    const int K = g.K, nt = K / BK;
    unsigned voffA[2], voffB[2];
#pragma unroll
    for (int i = 0; i < 2; ++i) { int R, C; stage_rc(tid * 16 + i * 8192, R, C); const int Rb = Epi::PERM ? ((R & ~31) + perm32(R & 31)) : R;
        voffA[i] = (unsigned)(R * K + C) * 2u; voffB[i] = (unsigned)(Rb * K + C) * 2u; }
    const size_t kstep = (size_t)(BK * 2);
    const size_t hstep = (size_t)HALF * K * 2;
    const size_t tstep = 2 * hstep;
    const size_t tstepA = TQ ? (size_t)192 * K * 2 : tstep;
    const unsigned ldsw = (unsigned)wid * 1024u;
    const int aoff = lds_byte(wr * 64 + fr, fq * 8), boff = lds_byte(wc * 32 + fr, fq * 8);
    const int aoff1 = TQ ? lds_byte(wr * 32 + fr, fq * 8) : aoff;
#define PG8_SA(b, h) (((b) * 2 + (h)) * HTB)
#define PG8_SB(b, h) ((4 + (b) * 2 + (h)) * HTB)
#define PG8_STAGE(bufoff, gbase, voff) do { _Pragma("unroll") for (int _i = 0; _i < 2; ++_i) \
        __builtin_amdgcn_global_load_lds((const unsigned*)((const char*)(gbase) + (voff)[_i]), (PG8_LAS unsigned*)(lds + (bufoff) + ldsw + _i * 8192), 16, 0, 0); } while (0)
#define PG8_STAGE_A1(bufoff, gbase, voff) do { if constexpr (TQ) __builtin_amdgcn_global_load_lds((const unsigned*)((const char*)(gbase) + (voff)[0]), (PG8_LAS unsigned*)(lds + (bufoff) + ldsw), 16, 0, 0); else PG8_STAGE(bufoff, gbase, voff); } while (0)
#define PG8_LDA(dst, b, h) do { _Pragma("unroll") for (int m = 0; m < 4; ++m) _Pragma("unroll") for (int k = 0; k < 2; ++k) dst[m][k] = *(const PG8_LAS bf16x8*)(lds + PG8_SA(b, h) + aoff + m * 2048 + k * 1024); } while (0)
#define PG8_LDA2(dst, b, h) do { if constexpr (TQ) { _Pragma("unroll") for (int m = 0; m < 2; ++m) _Pragma("unroll") for (int k = 0; k < 2; ++k) dst[m][k] = *(const PG8_LAS bf16x8*)(lds + PG8_SA(b, h) + aoff1 + m * 2048 + k * 1024); } else PG8_LDA(dst, b, h); } while (0)
#define PG8_LDB(dst, b, h) do { _Pragma("unroll") for (int n = 0; n < 2; ++n) _Pragma("unroll") for (int k = 0; k < 2; ++k) dst[n][k] = *(const PG8_LAS bf16x8*)(lds + PG8_SB(b, h) + boff + n * 2048 + k * 1024); } while (0)
#define PG8_MMA(ai, bj, At, Bt) do { __builtin_amdgcn_s_setprio(1); _Pragma("unroll") for (int m = 0; m < 4; ++m) _Pragma("unroll") for (int n = 0; n < 2; ++n) _Pragma("unroll") for (int k = 0; k < 2; ++k) \
        acc[ai][bj][m][n] = __builtin_amdgcn_mfma_f32_16x16x32_bf16(Bt[n][k], At[m][k], acc[ai][bj][m][n], 0, 0, 0); __builtin_amdgcn_s_setprio(0); } while (0)
#define PG8_MMA2(ai, bj, At, Bt) do { if constexpr (TQ) { __builtin_amdgcn_s_setprio(1); _Pragma("unroll") for (int m = 0; m < 2; ++m) _Pragma("unroll") for (int n = 0; n < 2; ++n) _Pragma("unroll") for (int k = 0; k < 2; ++k) \
        acc[ai][bj][m][n] = __builtin_amdgcn_mfma_f32_16x16x32_bf16(Bt[n][k], At[m][k], acc[ai][bj][m][n], 0, 0, 0); __builtin_amdgcn_s_setprio(0); } else PG8_MMA(ai, bj, At, Bt); } while (0)
#define PG8_WAIT_V(n) asm volatile("s_waitcnt vmcnt(" #n ")" ::: "memory")
#define PG8_WAIT_V8 do { if constexpr (TQ) PG8_WAIT_V(7); else PG8_WAIT_V(8); } while (0)
#define PG8_WAIT_L(n) asm volatile("s_waitcnt lgkmcnt(" #n ")" ::: "memory")
#define PG8_BAR __builtin_amdgcn_s_barrier()
#define PG8_SCHED __builtin_amdgcn_sched_barrier(0)
    Unit cur, nxt; int ui = 0;
    if (!S.next(0, cur)) return;
    f32x4 acc[2][2][4][2];
#pragma unroll
    for (int a = 0; a < 2; ++a)
#pragma unroll
        for (int b = 0; b < 2; ++b)
#pragma unroll
            for (int m = 0; m < 4; ++m)
#pragma unroll
                for (int n = 0; n < 2; ++n) acc[a][b][m][n] = (f32x4){0.f, 0.f, 0.f, 0.f};
    bf16x8 At[4][2], B0[2][2], B1[2][2];
    const char* cA = (const char*)g.A + (size_t)cur.pm * tstepA + (cur.half == 2 ? hstep : 0); const char* cB = (const char*)g.Bt + (size_t)cur.pn * tstep; size_t hA = cur.half ? 0 : hstep;
    S.a_ready(cur);
    if constexpr (SP2) {
        PG8_STAGE(PG8_SB(0, 0), cB, voffB); PG8_STAGE(PG8_SB(0, 1), cB + hstep, voffB); PG8_STAGE(PG8_SA(0, 0), cA, voffA); PG8_STAGE_A1(PG8_SA(0, 1), cA + hA, voffA);
        if (wr == 1) PG8_BAR;
        if constexpr (TQ) PG8_WAIT_V(1); else PG8_WAIT_V(2); PG8_BAR;
        PG8_STAGE(PG8_SB(1, 0), cB + kstep, voffB); PG8_STAGE(PG8_SA(1, 0), cA + kstep, voffA); PG8_STAGE(PG8_SB(1, 1), cB + hstep + kstep, voffB);
        PG8_WAIT_V(6); PG8_BAR;
    } else {
        PG8_STAGE(PG8_SB(0, 0), cB, voffB); PG8_STAGE(PG8_SA(0, 0), cA, voffA); PG8_STAGE(PG8_SB(0, 1), cB + hstep, voffB); PG8_STAGE(PG8_SA(0, 1), cA + hstep, voffA);
        if (wr == 1) PG8_BAR;
        PG8_WAIT_V(4); PG8_BAR;
        PG8_STAGE(PG8_SB(1, 0), cB + kstep, voffB); PG8_STAGE(PG8_SA(1, 0), cA + kstep, voffA); PG8_STAGE(PG8_SB(1, 1), cB + hstep + kstep, voffB);
        PG8_WAIT_V(6); PG8_BAR;
    }
    for (;;) {
        const bool has_next = S.next(ui + 1, nxt);
        const char* nA = has_next ? (const char*)g.A + (size_t)nxt.pm * tstepA + (nxt.half == 2 ? hstep : 0) : cA; const char* nB = has_next ? (const char*)g.Bt + (size_t)nxt.pn * tstep : cB;
        const size_t nhA = has_next ? (nxt.half ? 0 : hstep) : hA; const bool whole = cur.half == 0;
        for (int t = 0; t < nt; t += 2) {
            const bool last = (t == nt - 2);
            const char* a1 = cA + (size_t)(t + 1) * kstep;
            const char* a2 = last ? nA : cA + (size_t)(t + 2) * kstep; const char* b2 = last ? nB : cB + (size_t)(t + 2) * kstep;
            const char* a3 = a2 + kstep; const char* b3 = b2 + kstep;
            if (last && has_next) S.a_ready(nxt);
            if constexpr (SP2) {
            PG8_LDB(B0, 0, 0); PG8_LDB(B1, 0, 1); PG8_SCHED; PG8_LDA(At, 0, 0); PG8_STAGE_A1(PG8_SA(1, 1), a1 + hA, voffA);
            PG8_WAIT_V8; PG8_WAIT_L(0); PG8_BAR; PG8_MMA(0, 0, At, B0); PG8_MMA(0, 1, At, B1); PG8_BAR; PG8_SCHED;
            if (whole) PG8_LDA2(At, 0, 1); PG8_STAGE(PG8_SB(0, 0), b2, voffB); PG8_STAGE(PG8_SB(0, 1), b2 + hstep, voffB); PG8_STAGE(PG8_SA(0, 0), a2, voffA);
            PG8_WAIT_V8; PG8_WAIT_L(0); PG8_BAR; if (whole) { PG8_MMA2(1, 0, At, B0); PG8_MMA2(1, 1, At, B1); } PG8_BAR; PG8_SCHED;
            PG8_LDB(B0, 1, 0); PG8_LDB(B1, 1, 1); PG8_SCHED; PG8_LDA(At, 1, 0); PG8_STAGE_A1(PG8_SA(0, 1), a2 + (last ? nhA : hA), voffA);
            PG8_WAIT_V8; PG8_WAIT_L(0); PG8_BAR; PG8_MMA(0, 0, At, B0); PG8_MMA(0, 1, At, B1); PG8_BAR; PG8_SCHED;
            if (whole) PG8_LDA2(At, 1, 1); PG8_STAGE(PG8_SB(1, 0), b3, voffB); PG8_STAGE(PG8_SB(1, 1), b3 + hstep, voffB); PG8_STAGE(PG8_SA(1, 0), a3, voffA);
            PG8_WAIT_V8; PG8_WAIT_L(0); PG8_BAR; if (whole) { PG8_MMA2(1, 0, At, B0); PG8_MMA2(1, 1, At, B1); } PG8_BAR; PG8_SCHED;
            } else {
            PG8_LDB(B0, 0, 0); PG8_SCHED; PG8_LDA(At, 0, 0); PG8_STAGE(PG8_SA(1, 1), a1 + hstep, voffA);
            PG8_WAIT_L(8); PG8_BAR; PG8_WAIT_L(0); PG8_MMA(0, 0, At, B0); PG8_BAR; PG8_SCHED;
            PG8_LDB(B1, 0, 1); PG8_STAGE(PG8_SB(0, 0), b2, voffB);
            PG8_BAR; PG8_WAIT_L(0); PG8_MMA(0, 1, At, B1); PG8_BAR;
            PG8_LDA(At, 0, 1); PG8_STAGE(PG8_SA(0, 0), a2, voffA);
            PG8_BAR; PG8_WAIT_L(0); PG8_MMA(1, 0, At, B0); PG8_BAR; PG8_SCHED;
            PG8_STAGE(PG8_SB(0, 1), b2 + hstep, voffB);
            PG8_WAIT_V(6); PG8_BAR; PG8_MMA(1, 1, At, B1); PG8_BAR;
            PG8_LDB(B0, 1, 0); PG8_SCHED; PG8_LDA(At, 1, 0); PG8_STAGE(PG8_SA(0, 1), a2 + hstep, voffA);
            PG8_WAIT_L(8); PG8_BAR; PG8_WAIT_L(0); PG8_MMA(0, 0, At, B0); PG8_BAR; PG8_SCHED;
            PG8_LDB(B1, 1, 1); PG8_STAGE(PG8_SB(1, 0), b3, voffB);
            PG8_BAR; PG8_WAIT_L(0); PG8_MMA(0, 1, At, B1); PG8_BAR;
            PG8_LDA(At, 1, 1); PG8_STAGE(PG8_SA(1, 0), a3, voffA);
            PG8_BAR; PG8_WAIT_L(0); PG8_MMA(1, 0, At, B0); PG8_BAR; PG8_SCHED;
            PG8_STAGE(PG8_SB(1, 1), b3 + hstep, voffB);
            PG8_WAIT_V(6); PG8_BAR; PG8_MMA(1, 1, At, B1); PG8_BAR;
            }
        }
        if constexpr (ALIGN_EPI) { if (wr == 0) PG8_BAR; }
        if constexpr (!Epi::AFTER_DRAIN) { E(acc, cur, wr, wc, fr, fq); S.done(cur); }
        if (!has_next) break;
#pragma unroll
        for (int a = 0; a < 2; ++a)
#pragma unroll
            for (int b = 0; b < 2; ++b)
#pragma unroll
                for (int m = 0; m < 4; ++m)
#pragma unroll
                    for (int n = 0; n < 2; ++n) acc[a][b][m][n] = (f32x4){0.f, 0.f, 0.f, 0.f};
        cur = nxt; cA = nA; cB = nB; hA = nhA; ++ui;
        if constexpr (ALIGN_EPI) { if (wr == 1) PG8_BAR; }
    }
    PG8_WAIT_V(0);
    if constexpr (!ALIGN_EPI) { if (wr == 0) PG8_BAR; }
    PG8_BAR;
    if constexpr (Epi::AFTER_DRAIN) { E.fused(acc, cur, wr, wc, fr, fq, lds, wid, lane); S.done(cur); }
#undef PG8_SA
#undef PG8_SB
#undef PG8_STAGE
#undef PG8_LDA
#undef PG8_LDB
#undef PG8_MMA
#undef PG8_WAIT_V
#undef PG8_WAIT_L
#undef PG8_BAR
#undef PG8_SCHED
}
}
#define GAS __attribute__((address_space(1)))
#define XB_TMO      128
#define XB_XCNT(j)  (256  + 64 * (j))
#define XB_XSUB(j)  (1280 + 64 * (j))
#define XB_XGEN(j)  (2304 + 64 * (j))
#define XB_TOP      3328
#define XB_TOPGEN   3392
#define XCD_BAR_WORDS 3456
#define XB_SPIN_CAP (1u << 18)
#define LAS __attribute__((address_space(3)))

__device__ __forceinline__ unsigned xb_ld(unsigned* p)              { return __hip_atomic_load(p, __ATOMIC_RELAXED, __HIP_MEMORY_SCOPE_AGENT); }
__device__ __forceinline__ unsigned xb_add(unsigned* p, unsigned v) { return __hip_atomic_fetch_add(p, v, __ATOMIC_RELAXED, __HIP_MEMORY_SCOPE_AGENT); }
__device__ __forceinline__ unsigned xb_xcc_id() { return (unsigned)__builtin_amdgcn_s_getreg((3 << 11) | 20) & 0xFu; }
#define XB_SPIN(cond, bar) do { unsigned _sp = 0; while (cond) { __builtin_amdgcn_s_sleep(1); \
    if ((++_sp & 255u) == 0u) { if (xb_ld(&(bar)[XB_TMO])) break; if (_sp > XB_SPIN_CAP) { atomicAdd(&(bar)[XB_TMO], 1u); break; } } } } while (0)

struct XcdBarrier {
    unsigned* bar; unsigned x;
    volatile LAS unsigned* st;
};

__device__ __forceinline__ XcdBarrier xcd_barrier_post(unsigned* bar, volatile LAS unsigned* st) {
    XcdBarrier b; b.bar = bar; b.x = xb_xcc_id(); b.st = st;
    if (threadIdx.x == 0) (void)xb_add(&bar[XB_XCNT(b.x)], 1u);
    return b;
}
__device__ __forceinline__ void xcd_barrier_complete(unsigned* bar, unsigned x, unsigned& nloc, unsigned& nx) {
    const unsigned G = gridDim.x * gridDim.y * gridDim.z;
    unsigned sum, cnt, mine, sp = 0u;
    for (;;) {
        sum = 0u; cnt = 0u; mine = 0u;
#pragma unroll
        for (unsigned j = 0; j < 16; ++j) { const unsigned c = xb_ld(&bar[XB_XCNT(j)]); sum += c; cnt += (c > 0u) ? 1u : 0u; mine = (j == x) ? c : mine; }
        if (sum == G) break;
        __builtin_amdgcn_s_sleep(1);
        if ((++sp & 255u) == 0u) { if (xb_ld(&bar[XB_TMO])) break; if (sp > XB_SPIN_CAP) { atomicAdd(&bar[XB_TMO], 1u); break; } }
    }
    nloc = mine > 0u ? mine : 1u; nx = cnt > 0u ? cnt : 1u;
}

__device__ __forceinline__ void xcd_barrier(const XcdBarrier& b, const int tid_) {
    asm volatile("s_waitcnt vmcnt(0)" ::: "memory");
    __syncthreads();
    if (tid_ == 0) {
        unsigned* bar = b.bar;
        __builtin_amdgcn_s_waitcnt(0);
        unsigned nloc = b.st[0], nx = b.st[1];
        if (nloc == 0u) { xcd_barrier_complete(bar, b.x, nloc, nx); b.st[0] = nloc; b.st[1] = nx; }
        const unsigned old = xb_add(&bar[XB_XSUB(b.x)], 1u);
        const unsigned gen = old / nloc;
        if (old + 1u == (gen + 1u) * nloc) {
            __builtin_amdgcn_fence(__ATOMIC_RELEASE, "agent");
            asm volatile("s_waitcnt vmcnt(0)" ::: "memory");
            const unsigned og = xb_add(&bar[XB_TOP], 1u);
            const unsigned tg = og / nx;
            if (og + 1u == (tg + 1u) * nx) xb_add(&bar[XB_TOPGEN], 1u);
            else XB_SPIN(xb_ld(&bar[XB_TOPGEN]) == tg, bar);
            __builtin_amdgcn_fence(__ATOMIC_ACQUIRE, "agent");
            xb_add(&bar[XB_XGEN(b.x)], 1u);
            asm volatile("s_waitcnt vmcnt(0)" ::: "memory");
        } else {
            XB_SPIN(xb_ld(&bar[XB_XGEN(b.x)]) == gen, bar);
            __builtin_amdgcn_fence(__ATOMIC_ACQUIRE, "agent");
            asm volatile("s_waitcnt vmcnt(0)" ::: "memory");
        }
    }
    __syncthreads();
}

typedef unsigned short bf16_t;
typedef unsigned u32x4_t __attribute__((ext_vector_type(4)));
typedef float f32x4_t __attribute__((ext_vector_type(4)));
constexpr int D = 2048, MCTX = 4096, MLAT = 8192, M = MCTX + MLAT, DFF = 5632, NFF = 2 * DFF, PROJW = 5632, NPROJ = 5888, IN_COLS = 5648, ADA_N = 9 * D;
constexpr int DEPTH = 2, PAST = 512, LK_LAT = PAST + 4096;
constexpr float EPS = 1e-6f;
constexpr size_t MiB = 1u << 20;
constexpr size_t WS_CTL = 0, CTL_BYTES = 1 * MiB, WS_ADA = 1 * MiB, ADA_BYTES = (size_t)2 * 3 * ADA_N * 4, WS_LAM = 2 * MiB, WS_W = 16 * MiB;
constexpr size_t W_1IN = 0, W_1OUT = W_1IN + (size_t)NFF * D * 2, W_2IN = W_1OUT + (size_t)D * DFF * 2, W_2OUT = W_2IN + (size_t)NFF * D * 2, W_IN = W_2OUT + (size_t)D * DFF * 2,
                 W_OUT = W_IN + (size_t)NPROJ * D * 2, W_LAYER = W_OUT + (size_t)D * D * 2;
static_assert(WS_W + 2 * W_LAYER <= 344 * MiB, "weights");
constexpr size_t WS_X = 344 * MiB, WS_H = 440 * MiB, WS_CAT = 488 * MiB, WS_ACT = 536 * MiB, WS_PROJ = 668 * MiB, WS_AB = 800 * MiB, WS_GQ = 801 * MiB, WS_GK = 825 * MiB, WS_GV = 849 * MiB,
                 WS_GG = 873 * MiB, WS_GB = WS_GG + 512 * 1024, WS_OF = 874 * MiB, WS_OB = 898 * MiB, WS_QB = 922 * MiB, WS_KB = 938 * MiB, WS_VTL = 956 * MiB, WS_VTC = 1112 * MiB, WS_END = 1120 * MiB;
constexpr size_t OUT_YP = 0, OUT_YS = 8388608, OUT_CK = 25165824, OUT_CV = 33554432, OUT_ST = 41943040, OUT_TOTAL = 46137344;
constexpr int CW_BAR = 4096, CW_QUEUE = 16384;
constexpr int LDS_MISC = 147200, LDS_BYTES = 147456;
constexpr int NWAVES = 8;

__device__ __forceinline__ float bf2f(bf16_t b) { return __uint_as_float(((unsigned)b) << 16); }
__device__ __forceinline__ unsigned f2bf(float f) { unsigned u = __float_as_uint(f); return (u + 0x7fffu + ((u >> 16) & 1u)) >> 16; }
__device__ __forceinline__ unsigned pk2(float lo, float hi) { return f2bf(lo) | (f2bf(hi) << 16); }
__device__ __forceinline__ float lane_get(float v, int src_lane) { return __int_as_float(__builtin_amdgcn_ds_bpermute(src_lane << 2, __float_as_int(v))); }
__device__ __forceinline__ float wave_sum(float v, int lane) {
#pragma unroll
    for (int o = 1; o < 64; o <<= 1) v += lane_get(v, lane ^ o);
    return v;
}
__device__ __forceinline__ float silu(float x) { return x * __builtin_amdgcn_rcpf(1.0f + __expf(-x)); }
#define LDS_WAIT() asm volatile("s_waitcnt lgkmcnt(0)" ::: "memory")
__device__ __forceinline__ void row_geom(int row, int& seq0, int& L, int& t) { if (row < MCTX) { seq0 = row & ~255; L = 256; t = row & 255; } else { const int r = row - MCTX; seq0 = MCTX + (r & ~4095); L = 4096; t = r & 4095; } }

__device__ __forceinline__ int fresh_tid_w(int wave_s) { int t; asm volatile("v_mbcnt_lo_u32_b32 %0, -1, 0\n\tv_mbcnt_hi_u32_b32 %0, -1, %0" : "=v"(t)); return wave_s * 64 + t; }
struct Args { const float* in[27]; float* out; unsigned char* ws; };
struct Ptrs {
    const float *x_prompt, *x_sample, *c, *cache_k, *cache_v, *state_gdn, *c_ctx, *w_ada, *b_ada, *norm_ffn1, *ffn1_in, *ffn1_out, *norm_mix, *w_in, *gdn_conv, *gdn_a_log, *gdn_dt_bias, *gdn_norm,
                *diff_lam, *diff_norm, *pool_w, *pool_scale, *w_out, *norm_ffn2, *ffn2_in, *ffn2_out, *final_norm;
};

__device__ __forceinline__ int colmap(int mode, int n) {
    if (mode == 1) { const int t = n >> 8, r = n & 255; return r < 128 ? 128 * t + r : DFF + 128 * t + (r - 128); }
    if (mode == 2) { return n < 2048 ? n : (n < 5632 ? n + 16 : (n < 5648 ? 2048 + (n - 5632) : -1)); }
    return n;
}
typedef float f32x2pf_t __attribute__((ext_vector_type(2)));
__device__ __forceinline__ void tr_item(const float* __restrict__ src, int ld, bf16_t* __restrict__ dst, int Kdst, int mode, int item, int nblk, LAS float* scr, int lane,
                                        const float* __restrict__ pool_w, const float* __restrict__ pool_scale) {
    const int kb = item / nblk, nb = item - kb * nblk, k0 = 64 * kb, n0 = 32 * nb, nn = lane & 31, kh = lane >> 5;
    if (mode == 3 && k0 >= 1536) {
        const int gc0 = k0 - 1536, g = gc0 >> 7, ml = lane & 15, kq = lane >> 4;
        f32x4_t acc[4][2];
#pragma unroll
        for (int mt = 0; mt < 4; ++mt) { acc[mt][0] = (f32x4_t){0.f, 0.f, 0.f, 0.f}; acc[mt][1] = (f32x4_t){0.f, 0.f, 0.f, 0.f}; }
        const float* Ab = pool_w + (size_t)(gc0 + ml) * 128 + 4 * kq; const float* Sb = pool_scale + g * 128 + 4 * kq; const float* Bb = src + (size_t)(1536 + g * 128 + 4 * kq) * ld + n0 + 2 * ml;
#pragma unroll
        for (int s = 0; s < 8; ++s) { const f32x4_t sc4 = *(const f32x4_t*)(Sb + 16 * s); f32x4_t a4[4]; f32x2pf_t b2[4];
#pragma unroll
            for (int mt = 0; mt < 4; ++mt) a4[mt] = *(const f32x4_t*)(Ab + (size_t)mt * 16 * 128 + 16 * s) * sc4;
#pragma unroll
            for (int e = 0; e < 4; ++e) b2[e] = *(const f32x2pf_t*)(Bb + (size_t)(16 * s + e) * ld);
#pragma unroll
            for (int e = 0; e < 4; ++e)
#pragma unroll
                for (int mt = 0; mt < 4; ++mt) { acc[mt][0] = __builtin_amdgcn_mfma_f32_16x16x4f32(a4[mt][e], b2[e].x, acc[mt][0], 0, 0, 0); acc[mt][1] = __builtin_amdgcn_mfma_f32_16x16x4f32(a4[mt][e], b2[e].y, acc[mt][1], 0, 0, 0); } }
#pragma unroll
        for (int mt = 0; mt < 4; ++mt)
#pragma unroll
            for (int e = 0; e < 4; ++e) { scr[(16 * mt + 4 * kq + e) * 33 + 2 * ml] = acc[mt][0][e]; scr[(16 * mt + 4 * kq + e) * 33 + 2 * ml + 1] = acc[mt][1][e]; }
    } else {
        const int sc = colmap(mode == 3 ? 0 : mode, n0 + nn);
        float v[32];
#pragma unroll
        for (int i = 0; i < 32; ++i) v[i] = sc >= 0 ? __builtin_nontemporal_load(src + (size_t)(k0 + 2 * i + kh) * ld + sc) : 0.f;
#pragma unroll
        for (int i = 0; i < 32; ++i) scr[(2 * i + kh) * 33 + nn] = v[i];
    }
    LDS_WAIT();
    const int c = lane & 7;
#pragma unroll
    for (int j = 0; j < 4; ++j) { const int n = (lane >> 3) + 8 * j; const LAS float* s = scr + (8 * c) * 33 + n;
        u32x4_t o; o.x = pk2(s[0 * 33], s[1 * 33]); o.y = pk2(s[2 * 33], s[3 * 33]); o.z = pk2(s[4 * 33], s[5 * 33]); o.w = pk2(s[6 * 33], s[7 * 33]);
        *(u32x4_t*)(dst + (size_t)(n0 + n) * Kdst + k0 + 8 * c) = o; }
    LDS_WAIT();
}
constexpr int I_FIN = (D / 64) * (NFF / 32), I_FOUT = (DFF / 64) * (D / 32), I_WIN = (D / 64) * (NPROJ / 32), I_WOUT = (D / 64) * (D / 32), I_LAYER = 2 * I_FIN + 2 * I_FOUT + I_WIN + I_WOUT;
constexpr int DEFER_T = 8, SEG_F = 1024 * DEFER_T, SEG_W = 768 * DEFER_T, DEFER_ALL = I_LAYER - 512;
constexpr int DSEG0 = 0, DSEG1 = SEG_F, DSEG2 = SEG_F + SEG_W, DSEG3 = 2 * SEG_F + SEG_W, DSEG4 = 3 * SEG_F + SEG_W, DSEG5 = 3 * SEG_F + 2 * SEG_W, DSEG6 = DEFER_ALL;
constexpr int DM1 = I_FIN, DM2 = DM1 + I_FOUT, DM3 = DM2 + I_WIN, DM4 = DM3 + I_FIN, DM5 = DM4 + 1536;
static_assert(DSEG5 <= DSEG6 && DSEG6 - DSEG5 <= SEG_F, "last segment fits its tail");
static_assert(DM1 <= DSEG3, "layer 1 ffn1_in is complete after layer 0");
static_assert(DM2 <= DSEG4 && DM3 <= DSEG4, "ffn1_out and w_in are complete after layer 1's FFN1-in tail");
static_assert(DM4 <= DSEG5 && DM5 <= DSEG5, "ffn2_in and w_out are complete after layer 1's w_in tail");
__device__ __forceinline__ void ph_prologue(const Ptrs& p, unsigned char* ws, LAS unsigned char* lds, int gw, int NGW, int wave, int lane, int tid) {
    LAS float* sc = (LAS float*)lds;
    for (int i = tid; i < 3 * D; i += NWAVES * 64) { const int ci = i >> 11, k = i & 2047; sc[i] = silu(ci == 0 ? p.c_ctx[k] : p.c[(ci - 1) * D + k]); }
    __syncthreads();
    float* ada = (float*)(ws + WS_ADA);
    for (int it = gw; it < 2 * 144 * 32; it += NGW) {
        const int l = it / 4608, r = it - l * 4608, jb = r >> 5, ks = r & 31, j = jb * 128 + 2 * lane;
        const float* w = p.w_ada + ((size_t)l * D + ks * 64) * ADA_N + j;
        f32x2pf_t a0 = {0.f, 0.f}, a1 = {0.f, 0.f}, a2 = {0.f, 0.f};
#pragma unroll 16
        for (int k = 0; k < 64; ++k) { const f32x2pf_t wv = __builtin_nontemporal_load((const f32x2pf_t*)(w + (size_t)k * ADA_N)); a0 += wv * sc[ks * 64 + k]; a1 += wv * sc[D + ks * 64 + k]; a2 += wv * sc[2 * D + ks * 64 + k]; }
        if (ks == 0) { const f32x2pf_t b = *(const f32x2pf_t*)(p.b_ada + l * ADA_N + j); a0 += b; a1 += b; a2 += b; }
        float* o = ada + (size_t)l * 3 * ADA_N + j;
        atomicAdd(o, a0.x); atomicAdd(o + 1, a0.y); atomicAdd(o + ADA_N, a1.x); atomicAdd(o + ADA_N + 1, a1.y); atomicAdd(o + 2 * ADA_N, a2.x); atomicAdd(o + 2 * ADA_N + 1, a2.y);
    }
    if (gw == 0) {
        float* lam = (float*)(ws + WS_LAM);
        for (int l = 0; l < DEPTH; ++l) { const float* v = p.diff_lam + l * 256;
            const float s1 = wave_sum(v[lane] * v[64 + lane], lane), s2 = wave_sum(v[128 + lane] * v[192 + lane], lane);
            const float lam_init = 0.8f - 0.6f * expf(-0.3f * (float)l);
            if (lane == 0) { lam[l * 2] = expf(s1) - expf(s2) + lam_init; lam[l * 2 + 1] = lam_init; } }
    }
    LAS float* scr = (LAS float*)(lds + 24576 + wave * 8448);
    const int skip = NGW == 256 * NWAVES ? DEFER_ALL : 0;
    for (int it = (gw + NGW / 2) % NGW; it < 2 * I_LAYER - skip; it += NGW) {
        const int l = it >= I_LAYER ? 1 : 0; int r = l ? it - I_LAYER + skip : it; unsigned char* Wl = ws + WS_W + (size_t)l * W_LAYER;
        if (r < I_FIN) { tr_item(p.ffn1_in + (size_t)l * D * NFF, NFF, (bf16_t*)(Wl + W_1IN), D, 1, r, NFF / 32, scr, lane, nullptr, nullptr); continue; } r -= I_FIN;
        if (r < I_FIN) { tr_item(p.ffn2_in + (size_t)l * D * NFF, NFF, (bf16_t*)(Wl + W_2IN), D, 1, r, NFF / 32, scr, lane, nullptr, nullptr); continue; } r -= I_FIN;
        if (r < I_FOUT) { tr_item(p.ffn1_out + (size_t)l * DFF * D, D, (bf16_t*)(Wl + W_1OUT), DFF, 0, r, D / 32, scr, lane, nullptr, nullptr); continue; } r -= I_FOUT;
        if (r < I_FOUT) { tr_item(p.ffn2_out + (size_t)l * DFF * D, D, (bf16_t*)(Wl + W_2OUT), DFF, 0, r, D / 32, scr, lane, nullptr, nullptr); continue; } r -= I_FOUT;
        if (r < I_WIN) { tr_item(p.w_in + (size_t)l * D * IN_COLS, IN_COLS, (bf16_t*)(Wl + W_IN), D, 2, r, NPROJ / 32, scr, lane, nullptr, nullptr); continue; } r -= I_WIN;
        tr_item(p.w_out + (size_t)l * D * D, D, (bf16_t*)(Wl + W_OUT), D, 3, r, D / 32, scr, lane, p.pool_w + (size_t)l * 4 * 128 * 128, p.pool_scale + (size_t)l * 512);
    }
}
__device__ __forceinline__ void norm_row(const float* __restrict__ xrow, int row, const float* __restrict__ gain, const float* __restrict__ shift, const float* __restrict__ scale, bf16_t* __restrict__ H, float* xcopy, int lane) {
    const int cond = row < MCTX ? 0 : (row < MCTX + 4096 ? 1 : 2);
    const f32x4_t* xr = (const f32x4_t*)xrow + lane;
    const f32x4_t* gp = (const f32x4_t*)gain + lane; const f32x4_t* sh = (const f32x4_t*)(shift + (size_t)cond * ADA_N) + lane; const f32x4_t* sc = (const f32x4_t*)(scale + (size_t)cond * ADA_N) + lane;
    f32x4_t v[8], gq[8], aq[8], bq[8]; float ss = 0.f;
#pragma unroll
    for (int j = 0; j < 8; ++j) v[j] = xr[64 * j];
#pragma unroll
    for (int j = 0; j < 8; ++j) { gq[j] = gp[64 * j]; aq[j] = sh[64 * j]; bq[j] = sc[64 * j]; }
#pragma unroll
    for (int j = 0; j < 8; ++j) ss += (v[j].x * v[j].x + v[j].y * v[j].y) + (v[j].z * v[j].z + v[j].w * v[j].w);
    const float rstd = rsqrtf(wave_sum(ss, lane) * (1.0f / D) + EPS);
    if (xcopy) { f32x4_t* xc = (f32x4_t*)(xcopy + (size_t)row * D) + lane;
#pragma unroll
        for (int j = 0; j < 8; ++j) xc[64 * j] = v[j]; }
    unsigned long long* o8 = (unsigned long long*)(H + (size_t)row * D) + lane;
#pragma unroll
    for (int j = 0; j < 8; ++j) { const f32x4_t g = gq[j], a = aq[j], b = bq[j]; const f32x4_t y = v[j] * rstd * g * (b + 1.0f) + a;
        o8[64 * j] = (unsigned long long)pk2(y.x, y.y) | ((unsigned long long)pk2(y.z, y.w) << 32); }
}
__device__ __forceinline__ void final_norm_row(const float* __restrict__ X, int row, const float* __restrict__ gain, float* __restrict__ out, int lane) {
    const f32x4_t* xr = (const f32x4_t*)(X + (size_t)row * D) + lane; const f32x4_t* gp = (const f32x4_t*)gain + lane;
    f32x4_t v[8], gq[8]; float ss = 0.f;
#pragma unroll
    for (int j = 0; j < 8; ++j) v[j] = xr[64 * j];
#pragma unroll
    for (int j = 0; j < 8; ++j) gq[j] = gp[64 * j];
#pragma unroll
    for (int j = 0; j < 8; ++j) ss += (v[j].x * v[j].x + v[j].y * v[j].y) + (v[j].z * v[j].z + v[j].w * v[j].w);
    const float rstd = rsqrtf(wave_sum(ss, lane) * (1.0f / D) + EPS);
    f32x4_t* o = (f32x4_t*)(out + (size_t)row * D) + lane;
#pragma unroll
    for (int j = 0; j < 8; ++j) o[64 * j] = v[j] * rstd * gq[j];
}
__device__ __forceinline__ void unpack8(u32x4_t w, float (&f)[8]) { f[0] = __uint_as_float(w.x << 16); f[1] = __uint_as_float(w.x & 0xffff0000u); f[2] = __uint_as_float(w.y << 16); f[3] = __uint_as_float(w.y & 0xffff0000u);
    f[4] = __uint_as_float(w.z << 16); f[5] = __uint_as_float(w.z & 0xffff0000u); f[6] = __uint_as_float(w.w << 16); f[7] = __uint_as_float(w.w & 0xffff0000u); }
__device__ __forceinline__ u32x4_t pack8f(const float (&f)[8]) { u32x4_t w; w.x = pk2(f[0], f[1]); w.y = pk2(f[2], f[3]); w.z = pk2(f[4], f[5]); w.w = pk2(f[6], f[7]); return w; }
__device__ __forceinline__ void rope_load(int r, const bf16_t* __restrict__ P, int lane, u32x4_t (&xr)[4]) {
    const size_t prow = (size_t)(MCTX + r) * PROJW;
#pragma unroll
    for (int i = 0; i < 2; ++i) { const int task = lane + 64 * i, which = task >> 6, grp = (task >> 1) & 31, hj = task & 1, col = grp * 32 + 8 * hj;
        const bf16_t* src = P + prow + (which ? 3072 : 2048) + col; xr[2 * i] = *(const u32x4_t*)src; xr[2 * i + 1] = *(const u32x4_t*)(src + 16); }
}
__device__ __forceinline__ void rope_finish(int r, const u32x4_t (&xr)[4], bf16_t* __restrict__ QB, bf16_t* __restrict__ KB, const LAS float* tab, int lane) {
    const int b = r >> 12, t = r & 4095;
#pragma unroll
    for (int i = 0; i < 2; ++i) { const int task = lane + 64 * i, which = task >> 6, grp = (task >> 1) & 31, hj = task & 1, col = grp * 32 + 8 * hj;
        const int pos = (grp & 1) ? (t & 63) : (t >> 6);
        float x1[8], x2[8], o1[8], o2[8]; unpack8(xr[2 * i], x1); unpack8(xr[2 * i + 1], x2);
        const LAS float* tp = tab + (pos * 16 + 8 * hj) * 2;
#pragma unroll
        for (int e = 0; e < 8; ++e) { const float cs = tp[2 * e], sn = tp[2 * e + 1]; o1[e] = x1[e] * cs - x2[e] * sn; o2[e] = x1[e] * sn + x2[e] * cs; }
        bf16_t* dst = which ? KB + ((size_t)b * LK_LAT + PAST + t) * 1024 + col : QB + (size_t)r * 1024 + col;
        *(u32x4_t*)dst = pack8f(o1); *(u32x4_t*)(dst + 16) = pack8f(o2); }
}
__device__ __forceinline__ void pool_row(int row, const bf16_t* __restrict__ P, bf16_t* __restrict__ CAT, int lane) {
    int seq0, L, t; row_geom(row, seq0, L, t);
    const int w = 2 << (lane >> 4), a = w >> 1, bb = w - a - 1, lo = t - a < 0 ? 0 : t - a, hi = t + bb + 1 > L ? L : t + bb + 1;
    float s[8], x[8]; u32x4_t tap[16];
#pragma unroll
    for (int o = 0; o < 16; ++o) { const int tt = t + o - 8; tap[o] = *(const u32x4_t*)(P + (size_t)(seq0 + ((tt >= lo && tt < hi) ? tt : t)) * PROJW + 5120 + 8 * lane); }
#pragma unroll
    for (int e = 0; e < 8; ++e) s[e] = 0.f;
#pragma unroll
    for (int o = 0; o < 16; ++o) { const int tt = t + o - 8; const float wgt = (tt >= lo && tt < hi) ? 1.0f : 0.0f; float v[8]; unpack8(tap[o], v);
#pragma unroll
        for (int e = 0; e < 8; ++e) s[e] += v[e] * wgt; }
    unpack8(*(const u32x4_t*)(P + (size_t)row * PROJW + 5120 + 8 * lane), x);
    const float inv = 1.0f / (float)(hi - lo);
#pragma unroll
    for (int e = 0; e < 8; ++e) s[e] = s[e] * inv - x[e];
    *(u32x4_t*)(CAT + (size_t)row * D + 1536 + 8 * lane) = pack8f(s);
}
__device__ __forceinline__ void gdn_out_row(int row, const float* __restrict__ OF, const float* __restrict__ OB, const bf16_t* __restrict__ P, const float* __restrict__ gnorm, bf16_t* __restrict__ CAT, int lane) {
    const size_t o = (size_t)row * 512 + 8 * lane; const int c0 = 8 * (lane & 15);
    const f32x4_t f0 = *(const f32x4_t*)(OF + o), f1 = *(const f32x4_t*)(OF + o + 4), b0 = *(const f32x4_t*)(OB + o), b1 = *(const f32x4_t*)(OB + o + 4);
    const u32x4_t zr = *(const u32x4_t*)(P + (size_t)row * PROJW + 1536 + 8 * lane);
    const f32x4_t g0 = *(const f32x4_t*)(gnorm + c0), g1 = *(const f32x4_t*)(gnorm + c0 + 4);
    const f32x4_t x0 = f0 + b0, x1 = f1 + b1;
    float ss = ((x0.x * x0.x + x0.y * x0.y) + (x0.z * x0.z + x0.w * x0.w)) + ((x1.x * x1.x + x1.y * x1.y) + (x1.z * x1.z + x1.w * x1.w));
    ss += lane_get(ss, lane ^ 1); ss += lane_get(ss, lane ^ 2); ss += lane_get(ss, lane ^ 4); ss += lane_get(ss, lane ^ 8);
    const float r = rsqrtf(ss * (1.0f / 128.0f) + EPS);
    float z[8], y[8]; unpack8(zr, z);
    y[0] = x0.x * r * g0.x * silu(z[0]); y[1] = x0.y * r * g0.y * silu(z[1]); y[2] = x0.z * r * g0.z * silu(z[2]); y[3] = x0.w * r * g0.w * silu(z[3]);
    y[4] = x1.x * r * g1.x * silu(z[4]); y[5] = x1.y * r * g1.y * silu(z[5]); y[6] = x1.z * r * g1.z * silu(z[6]); y[7] = x1.w * r * g1.w * silu(z[7]);
    *(u32x4_t*)(CAT + (size_t)row * D + 8 * lane) = pack8f(y);
}
constexpr int GBLK_W = 0, GBLK_Q = 16384, GBLK_K = 32768, GBLK_A = 49152, GBLK_U = 57344, GBLK_GL = 90112, GBLK_BYTES = 92160, GBLK_DMA = 57344;
constexpr size_t WS_GBLK = 974 * MiB;
static_assert(WS_GBLK + (size_t)1536 * GBLK_BYTES <= 1152 * MiB, "gdn blocks");
typedef short bf16x8_t __attribute__((ext_vector_type(8)));
typedef __bf16 bf16x2v_t __attribute__((ext_vector_type(2)));
typedef float f32x2v_t __attribute__((ext_vector_type(2)));
__device__ __forceinline__ unsigned cvt2(float lo, float hi) { f32x2v_t v = {lo, hi}; bf16x2v_t b = __builtin_convertvector(v, bf16x2v_t); return __builtin_bit_cast(unsigned, b); }
__device__ __forceinline__ bf16x8_t pack8(f32x4_t a, f32x4_t b) { u32x4_t w; w.x = cvt2(a.x, a.y); w.y = cvt2(a.z, a.w); w.z = cvt2(b.x, b.y); w.w = cvt2(b.z, b.w); return __builtin_bit_cast(bf16x8_t, w); }
__device__ __forceinline__ int img_byte(int r, int c) { const int st = (r >> 4) * 2 + (c >> 5), rr = r & 15, cc = c & 31, ob = rr * 64 + cc * 2; return st * 1024 + (ob ^ (((ob >> 9) & 1) << 5)); }
__device__ __forceinline__ int posinv(int x) { const int g = x & ~31, y = x & 31; return g + 8 * ((y >> 2) & 3) + 4 * (y >> 4) + (y & 3); }
__device__ __forceinline__ int gdn_block_index(int b, int dir, int h, int n, bool lat) { return lat ? 512 + (((b * 2 + dir) * 4 + h) * 64 + n) : ((b * 2 + dir) * 4 + h) * 4 + n; }

__device__ __forceinline__ void gdn_prep_item(int item, const bf16_t* __restrict__ P, const float* __restrict__ AB, const float* __restrict__ conv, const float* __restrict__ a_log, const float* __restrict__ dt_bias,
                                              unsigned char* __restrict__ gblk, LAS unsigned char* lds, int tid) {
    asm volatile("" : "+v"(tid));
    int vz = 0; asm volatile("" : "+v"(vz));
    LAS float* kf = (LAS float*)lds + vz; LAS float* vf = kf + 64 * 132; LAS unsigned char* R2 = (LAS unsigned char*)(vf + 64 * 132); LAS float* R3 = (LAS float*)(R2 + 32768); LAS float* sm = R3 + 8192;
    int b, nb, h, seq0, NC; bool lat;
    if (item < 256) { lat = false; b = item >> 4; nb = (item >> 2) & 3; h = item & 3; seq0 = b * 256; NC = 4; }
    else { const int i2 = item - 256; lat = true; b = i2 >> 8; nb = (i2 >> 2) & 63; h = i2 & 3; seq0 = MCTX + b * 4096; NC = 64; }
    const int t0 = nb * 64, Lseq = NC * 64;
    unsigned char* blk0 = gblk + (size_t)gdn_block_index(b, 0, h, nb, lat) * GBLK_BYTES;
    unsigned char* blk1 = gblk + (size_t)gdn_block_index(b, 1, h, NC - 1 - nb, lat) * GBLK_BYTES;
    const int lane = tid & 63, wave = tid >> 6, fr = lane & 15, fq = lane >> 4;
    __syncthreads();
    u32x4_t xr[6][4];
#pragma unroll
    for (int i = 0; i < 6; ++i) { const int id = tid + 512 * i, c = id / 48, r48 = id - c * 48, part = r48 >> 4, ch8 = (r48 & 15) * 8, tok = t0 + c, col = part * 512 + h * 128 + ch8;
#pragma unroll
        for (int j = 0; j < 4; ++j) { const int tt = tok + j - 2; const bool ok = tt >= 0 && tt < Lseq; xr[i][j] = *(const u32x4_t*)(P + (size_t)(seq0 + (ok ? tt : tok)) * PROJW + col); } }
#pragma unroll
    for (int i = 0; i < 6; ++i) { const int id = tid + 512 * i, c = id / 48, r48 = id - c * 48, part = r48 >> 4, ch8 = (r48 & 15) * 8, tok = t0 + c, col = part * 512 + h * 128 + ch8;
        float acc[8];
#pragma unroll
        for (int e = 0; e < 8; ++e) acc[e] = 0.f;
#pragma unroll
        for (int j = 0; j < 4; ++j) { const int tt = tok + j - 2; const float vm = (tt >= 0 && tt < Lseq) ? 1.0f : 0.0f; float x[8]; unpack8(xr[i][j], x);
            const f32x4_t w0 = *(const f32x4_t*)(conv + j * 1536 + col) * vm, w1 = *(const f32x4_t*)(conv + j * 1536 + col + 4) * vm;
            acc[0] += x[0] * w0.x; acc[1] += x[1] * w0.y; acc[2] += x[2] * w0.z; acc[3] += x[3] * w0.w; acc[4] += x[4] * w1.x; acc[5] += x[5] * w1.y; acc[6] += x[6] * w1.z; acc[7] += x[7] * w1.w; }
        LAS float* dst = part == 0 ? R3 + c * 128 + ch8 : (part == 1 ? kf : vf) + c * 132 + ch8;
        *(LAS f32x4_t*)dst = (f32x4_t){silu(acc[0]), silu(acc[1]), silu(acc[2]), silu(acc[3])}; *(LAS f32x4_t*)(dst + 4) = (f32x4_t){silu(acc[4]), silu(acc[5]), silu(acc[6]), silu(acc[7])}; }
    if (wave < 2) {
        const int d = wave; const size_t row = (size_t)(seq0 + t0 + (d ? 63 - lane : lane));
        const float av = AB[row * 16 + d * 4 + h] + dt_bias[d * 4 + h], bv = AB[row * 16 + 8 + d * 4 + h];
        float g = -__expf(a_log[d * 4 + h]) * (fmaxf(av, 0.f) + __logf(1.0f + __expf(-fabsf(av)))); const float beta = 1.0f / (1.0f + __expf(-bv));
#pragma unroll
        for (int o = 1; o < 64; o <<= 1) { const float t = lane_get(g, (lane - o) & 63); if (lane >= o) g += t; }
        const float glast = lane_get(g, 63);
        LAS float* s = sm + d * 256; s[lane] = g; s[64 + lane] = beta; s[128 + lane] = __expf(g); s[192 + lane] = __expf(glast - g);
        if (lane == 0) *(float*)((d ? blk1 : blk0) + GBLK_GL) = __expf(glast);
    }
    __syncthreads();
    { const int c = tid >> 3, part = (tid >> 2) & 1, q4 = tid & 3; LAS float* rowp = part ? kf + c * 132 + 32 * q4 : R3 + c * 128 + 32 * q4; float ss = 0.f; f32x4_t v[8];
#pragma unroll
      for (int e = 0; e < 8; ++e) { v[e] = *(const LAS f32x4_t*)(rowp + 4 * e); ss += (v[e].x * v[e].x + v[e].y * v[e].y) + (v[e].z * v[e].z + v[e].w * v[e].w); }
      ss += lane_get(ss, lane ^ 1); ss += lane_get(ss, lane ^ 2);
      const float r = rsqrtf(ss + EPS) * (part ? 1.0f : 0.08838834764831845f);
      LAS unsigned char* img = R2 + (part ? 0 : 16384);
#pragma unroll
      for (int e = 0; e < 8; ++e) v[e] = v[e] * r;
      if (part) {
#pragma unroll
          for (int e = 0; e < 8; ++e) *(LAS f32x4_t*)(rowp + 4 * e) = v[e]; }
#pragma unroll
      for (int e2 = 0; e2 < 4; ++e2) { const int col = 32 * q4 + 8 * e2; u32x4_t w; w.x = pk2(v[2 * e2].x, v[2 * e2].y); w.y = pk2(v[2 * e2].z, v[2 * e2].w); w.z = pk2(v[2 * e2 + 1].x, v[2 * e2 + 1].y); w.w = pk2(v[2 * e2 + 1].z, v[2 * e2 + 1].w);
          *(LAS u32x4_t*)(img + img_byte(c + 64 * (col >> 6), col & 63)) = w; } }
    __syncthreads();
    f32x4_t kk[2], qk[2];
    { const int aoff = img_byte(fr, fq * 8), it = wave >> 1, jt0 = 2 * (wave & 1);
      kk[0] = kk[1] = qk[0] = qk[1] = (f32x4_t){0.f, 0.f, 0.f, 0.f};
#pragma unroll
      for (int ks = 0; ks < 4; ++ks) { const int ko = 4 * (ks >> 1) * 2048 + (ks & 1) * 1024;
          const bf16x8_t xk = *(const LAS bf16x8_t*)(R2 + aoff + it * 2048 + ko), xq = *(const LAS bf16x8_t*)(R2 + 16384 + aoff + it * 2048 + ko);
#pragma unroll
          for (int jj = 0; jj < 2; ++jj) { const bf16x8_t yk = *(const LAS bf16x8_t*)(R2 + aoff + (jt0 + jj) * 2048 + ko);
              kk[jj] = __builtin_amdgcn_mfma_f32_16x16x32_bf16(xk, yk, kk[jj], 0, 0, 0); qk[jj] = __builtin_amdgcn_mfma_f32_16x16x32_bf16(xq, yk, qk[jj], 0, 0, 0); } } }
#pragma unroll
    for (int i = 0; i < 4; ++i) { const int id = tid + 512 * i, d = id >> 10, r = id & 1023, c = r >> 4, p8 = r & 15, ks = p8 >> 2, fq2 = p8 & 3, tc = d ? 63 - c : c; const float e = sm[d * 256 + 128 + c];
        const int dk0 = 32 * ks + 4 * fq2, dk1 = dk0 + 16;
        const unsigned long long a = *(const LAS unsigned long long*)(R2 + 16384 + img_byte(tc + 64 * (dk0 >> 6), dk0 & 63)), bq = *(const LAS unsigned long long*)(R2 + 16384 + img_byte(tc + 64 * (dk1 >> 6), dk1 & 63));
        u32x4_t w; w.x = pk2(__uint_as_float((unsigned)a << 16) * e, __uint_as_float((unsigned)a & 0xffff0000u) * e); w.y = pk2(__uint_as_float((unsigned)(a >> 32) << 16) * e, __uint_as_float((unsigned)(a >> 32) & 0xffff0000u) * e);
        w.z = pk2(__uint_as_float((unsigned)bq << 16) * e, __uint_as_float((unsigned)bq & 0xffff0000u) * e); w.w = pk2(__uint_as_float((unsigned)(bq >> 32) << 16) * e, __uint_as_float((unsigned)(bq >> 32) & 0xffff0000u) * e);
        const int pos = 8 * p8; *(u32x4_t*)((d ? blk1 : blk0) + GBLK_Q + img_byte(c + 64 * (pos >> 6), pos & 63)) = w; }
#pragma unroll
    for (int i = 0; i < 4; ++i) { const int id = tid + 512 * i, d = id >> 10, r = id & 1023, dk = r & 127, p8 = r >> 7, grp = p8 >> 2, fq2 = p8 & 3; float v[8];
#pragma unroll
        for (int e = 0; e < 8; ++e) { const int c = 32 * grp + 16 * (e >> 2) + 4 * fq2 + (e & 3), tc = d ? 63 - c : c; v[e] = kf[tc * 132 + dk] * sm[d * 256 + 192 + c]; }
        u32x4_t w; w.x = pk2(v[0], v[1]); w.y = pk2(v[2], v[3]); w.z = pk2(v[4], v[5]); w.w = pk2(v[6], v[7]);
        *(u32x4_t*)((d ? blk1 : blk0) + GBLK_K + img_byte(dk, 8 * p8)) = w; }
    __syncthreads();
    { const int it = wave >> 1, jt0 = 2 * (wave & 1); LAS float* KKs = (LAS float*)R2; LAS float* QKs = KKs + 4096;
#pragma unroll
      for (int jj = 0; jj < 2; ++jj)
#pragma unroll
          for (int e = 0; e < 4; ++e) { const int i = 16 * it + 4 * fq + e, j = 16 * (jt0 + jj) + fr; KKs[i * 64 + j] = kk[jj][e]; QKs[i * 64 + j] = qk[jj][e]; } }
    __syncthreads();
    { const LAS float* KKs = (const LAS float*)R2; const LAS float* QKs = KKs + 4096;
#pragma unroll
      for (int i = 0; i < 4; ++i) { const int id = tid + 512 * i, d = id >> 10, r = id & 1023, c = r >> 4, j0 = 4 * (r & 15), tc = d ? 63 - c : c; const LAS float* s = sm + d * 256; const float gcc = s[c], bc = s[64 + c];
          float lv[4], av[4];
#pragma unroll
          for (int e = 0; e < 4; ++e) { const int j = j0 + e, tj = d ? 63 - j : j; const float dec = __expf(fminf(gcc - s[j], 0.f));
              lv[e] = c > j ? bc * KKs[tc * 64 + tj] * dec : 0.f; av[e] = c >= j ? QKs[tc * 64 + tj] * dec : 0.f; }
          *(LAS f32x4_t*)(R3 + d * 4096 + c * 64 + j0) = (f32x4_t){lv[0], lv[1], lv[2], lv[3]};
          *(unsigned long long*)((d ? blk1 : blk0) + GBLK_A + img_byte(c, posinv(j0))) = (unsigned long long)pk2(av[0], av[1]) | ((unsigned long long)pk2(av[2], av[3]) << 32); } }
    __syncthreads();
    const int d = wave >> 2, w4 = wave & 3, colu = (w4 & 1) * 64 + lane; const LAS float* smd = sm + d * 256; const LAS float* Lm = R3 + d * 4096;
    float U[64];
#pragma unroll
    for (int c = 0; c < 64; ++c) { const int tc = d ? 63 - c : c; U[c] = w4 < 2 ? smd[64 + c] * vf[tc * 132 + colu] : smd[64 + c] * smd[128 + c] * kf[tc * 132 + colu]; }
    __syncthreads();
#pragma unroll
    for (int c = 1; c < 64; ++c) {
        f32x4_t l4[16];
#pragma unroll
        for (int j4 = 0; j4 < (c + 3) / 4; ++j4) l4[j4] = *(const LAS f32x4_t*)(Lm + c * 64 + 4 * j4);
        __builtin_amdgcn_sched_barrier(0);
        float acc = U[c], acc2 = 0.f;
#pragma unroll
        for (int j4 = 0; j4 < (c + 3) / 4; ++j4) {
            acc -= l4[j4].x * U[4 * j4]; if (4 * j4 + 1 < c) acc2 -= l4[j4].y * U[4 * j4 + 1]; if (4 * j4 + 2 < c) acc -= l4[j4].z * U[4 * j4 + 2]; if (4 * j4 + 3 < c) acc2 -= l4[j4].w * U[4 * j4 + 3]; }
        U[c] = acc + acc2;
        __builtin_amdgcn_sched_barrier(0); }
    unsigned char* blk = d ? blk1 : blk0;
    LAS unsigned short* wimg = (LAS unsigned short*)((LAS unsigned char*)vf + d * 16384);
    if (w4 < 2) {
        const int ds = colu >> 4, f16 = colu & 15; float* ub = (float*)(blk + GBLK_U);
#pragma unroll
        for (int c4 = 0; c4 < 16; ++c4) { const int ct = c4 >> 2, fq2 = c4 & 3; *(f32x4_t*)(ub + ((ds * 4 + ct) * 64 + fq2 * 16 + f16) * 4) = (f32x4_t){U[4 * c4], U[4 * c4 + 1], U[4 * c4 + 2], U[4 * c4 + 3]}; }
    } else {
        const int pos = posinv(colu), rofs = 64 * (pos >> 6), col = pos & 63;
#pragma unroll
        for (int c = 0; c < 64; ++c) wimg[img_byte(c + rofs, col) >> 1] = (unsigned short)f2bf(-U[c]);
    }
    __syncthreads();
#pragma unroll
    for (int i = 0; i < 4; ++i) { const int o = (tid + 512 * i) * 16, dd = o >> 14, oo = o & 16383; *(u32x4_t*)((dd ? blk1 : blk0) + GBLK_W + oo) = *(const LAS u32x4_t*)((LAS unsigned char*)vf + o); }
}

__device__ __forceinline__ void gdn_scan_chain(int chain, const unsigned char* __restrict__ gblk, float* __restrict__ OF, float* __restrict__ OB, const float* __restrict__ state_in, float* __restrict__ state_out,
                                               int layer, LAS unsigned char* lds, int tid) {
    const int lane = tid & 63, wave = __builtin_amdgcn_readfirstlane(tid >> 6), fr = lane & 15, fq = lane >> 4, dv = wave * 16 + fr;
    int b, dir, h, seq0, NC, blk0; bool lat;
    if (chain < 128) { lat = false; b = chain >> 3; dir = (chain >> 2) & 1; h = chain & 3; seq0 = b * 256; NC = 4; blk0 = chain * 4; }
    else { const int c2 = chain - 128; lat = true; b = c2 >> 3; dir = (c2 >> 2) & 1; h = c2 & 3; seq0 = MCTX + b * 4096; NC = 64; blk0 = 512 + c2 * 64; }
    const int L = NC * 64;
    f32x4_t S[8];
    const size_t sbase = ((((size_t)b * 2 + layer) * 2 + dir) * 4 + h) * 16384;
    if (lat) {
#pragma unroll
        for (int dt = 0; dt < 8; ++dt)
#pragma unroll
            for (int e = 0; e < 4; ++e) S[dt][e] = state_in[sbase + (size_t)(16 * dt + 4 * fq + e) * 128 + dv]; }
    else {
#pragma unroll
        for (int dt = 0; dt < 8; ++dt) S[dt] = (f32x4_t){0.f, 0.f, 0.f, 0.f}; }
    float* O = dir ? OB : OF;
    const int aoff = img_byte(fr, fq * 8);
    __syncthreads();
    { const unsigned char* src = gblk + (size_t)blk0 * GBLK_BYTES + wave * 1024 + lane * 16;
#pragma unroll
      for (int i = 0; i < 7; ++i) __builtin_amdgcn_global_load_lds((const unsigned*)(src + i * 8192), (LAS unsigned*)(lds + i * 8192 + wave * 1024), 16, 0, 0); }
    f32x4_t ucur[4], unext[4];
    { const float* ub = (const float*)(gblk + (size_t)blk0 * GBLK_BYTES + GBLK_U);
#pragma unroll
      for (int ct = 0; ct < 4; ++ct) ucur[ct] = *(const f32x4_t*)(ub + ((wave * 4 + ct) * 64 + lane) * 4); }
    for (int n = 0; n < NC; ++n) {
        asm volatile("s_waitcnt vmcnt(0)" ::: "memory");
        __builtin_amdgcn_s_barrier();
        asm volatile("" ::: "memory");
        const unsigned char* cblk = gblk + (size_t)(blk0 + n) * GBLK_BYTES;
        LAS unsigned char* buf = lds + (n & 1) * GBLK_DMA;
        if (n + 1 < NC) {
            const unsigned char* src = cblk + GBLK_BYTES + wave * 1024 + lane * 16; LAS unsigned char* nb = lds + ((n + 1) & 1) * GBLK_DMA;
#pragma unroll
            for (int i = 0; i < 7; ++i) __builtin_amdgcn_global_load_lds((const unsigned*)(src + i * 8192), (LAS unsigned*)(nb + i * 8192 + wave * 1024), 16, 0, 0);
            const float* ub = (const float*)(cblk + GBLK_BYTES + GBLK_U);
#pragma unroll
            for (int ct = 0; ct < 4; ++ct) unext[ct] = *(const f32x4_t*)(ub + ((wave * 4 + ct) * 64 + lane) * 4);
        }
        const float gl = *(const float*)(cblk + GBLK_GL);
        bf16x8_t Ys[4];
#pragma unroll
        for (int ks = 0; ks < 4; ++ks) Ys[ks] = pack8(S[2 * ks], S[2 * ks + 1]);
        f32x4_t av[4], ao[4];
#pragma unroll
        for (int ct = 0; ct < 4; ++ct) { av[ct] = ucur[ct]; ao[ct] = (f32x4_t){0.f, 0.f, 0.f, 0.f}; }
#pragma unroll
        for (int ct = 0; ct < 4; ++ct)
#pragma unroll
            for (int ks = 0; ks < 4; ++ks) { const int o = aoff + (ct + 4 * (ks >> 1)) * 2048 + (ks & 1) * 1024;
                const bf16x8_t xw = *(const LAS bf16x8_t*)(buf + GBLK_W + o), xq = *(const LAS bf16x8_t*)(buf + GBLK_Q + o);
                av[ct] = __builtin_amdgcn_mfma_f32_16x16x32_bf16(xw, Ys[ks], av[ct], 0, 0, 0);
                ao[ct] = __builtin_amdgcn_mfma_f32_16x16x32_bf16(xq, Ys[ks], ao[ct], 0, 0, 0); }
        bf16x8_t Yv[2];
#pragma unroll
        for (int ks = 0; ks < 2; ++ks) Yv[ks] = pack8(av[2 * ks], av[2 * ks + 1]);
#pragma unroll
        for (int ct = 0; ct < 4; ++ct)
#pragma unroll
            for (int ks = 0; ks < 2; ++ks) { const bf16x8_t xa = *(const LAS bf16x8_t*)(buf + GBLK_A + aoff + ct * 2048 + ks * 1024);
                ao[ct] = __builtin_amdgcn_mfma_f32_16x16x32_bf16(xa, Yv[ks], ao[ct], 0, 0, 0); }
#pragma unroll
        for (int dt = 0; dt < 8; ++dt) { S[dt] = S[dt] * gl;
#pragma unroll
            for (int ks = 0; ks < 2; ++ks) { const bf16x8_t xk = *(const LAS bf16x8_t*)(buf + GBLK_K + aoff + dt * 2048 + ks * 1024);
                S[dt] = __builtin_amdgcn_mfma_f32_16x16x32_bf16(xk, Yv[ks], S[dt], 0, 0, 0); } }
#pragma unroll
        for (int ct = 0; ct < 4; ++ct)
#pragma unroll
            for (int e = 0; e < 4; ++e) { const int s = n * 64 + 16 * ct + 4 * fq + e, t = dir ? L - 1 - s : s; O[(size_t)(seq0 + t) * 512 + h * 128 + dv] = ao[ct][e]; }
#pragma unroll
        for (int ct = 0; ct < 4; ++ct) ucur[ct] = unext[ct];
    }
    if (!lat) {
#pragma unroll
        for (int dt = 0; dt < 8; ++dt)
#pragma unroll
            for (int e = 0; e < 4; ++e) state_out[sbase + (size_t)(16 * dt + 4 * fq + e) * 128 + dv] = S[dt][e]; }
    asm volatile("s_waitcnt vmcnt(0)" ::: "memory");
    __syncthreads();
}
__device__ __forceinline__ float xrow_max(float x) {
    auto s = __builtin_amdgcn_permlane16_swap(__float_as_uint(x), __float_as_uint(x), false, false); x = fmaxf(__uint_as_float(s[0]), __uint_as_float(s[1]));
    auto t = __builtin_amdgcn_permlane32_swap(__float_as_uint(x), __float_as_uint(x), false, false); return fmaxf(__uint_as_float(t[0]), __uint_as_float(t[1])); }
__device__ __forceinline__ void attn_stage_rc(int bb, int& R, int& C) { const int st = bb / 1024, sb = bb % 1024, swz = sb ^ (((sb >> 9) & 1) << 5); R = (st >> 1) * 16 + swz / 64; C = (st & 1) * 32 + (swz % 64) / 2; }
#ifndef ATT_FIXTHR
#define ATT_FIXTHR 8.0f
#endif
__device__ __forceinline__ void attn_unit(const bf16_t* __restrict__ Q, int ldq, const bf16_t* __restrict__ K, int ldk, const bf16_t* __restrict__ VT, int ldv, int NJ,
                                          const float* __restrict__ lamp, const float* __restrict__ dnorm, bf16_t* __restrict__ CATrow0, LAS unsigned char* lds, int tid, float* __restrict__ part) {
    const int lane = tid & 63, wave = __builtin_amdgcn_readfirstlane(tid >> 6), fr = lane & 15, fq = lane >> 4, comp = wave >> 2, wq = wave & 3;
    const float SC = 0.18033688011112042f;
    const float FIXTHR = ATT_FIXTHR;
    unsigned voffK, voffV[2];
    { int R, C; attn_stage_rc(tid * 16, R, C); voffK = (unsigned)(R * ldk + C) * 2u; voffV[0] = (unsigned)(R * ldv + C) * 2u; attn_stage_rc(tid * 16 + 8192, R, C); voffV[1] = (unsigned)(R * ldv + C) * 2u; }
    const int aoff = img_byte(fr, fq * 8);
    bf16x8_t Qf[2]; u32x4_t qraw[2];
#pragma unroll
    for (int ks = 0; ks < 2; ++ks) qraw[ks] = *(const u32x4_t*)(Q + (size_t)(16 * wq + fr) * ldq + comp * 64 + 32 * ks + 8 * fq);
#define ATT_QCONV() _Pragma("unroll") for (int ks = 0; ks < 2; ++ks) { float qf8[8]; unpack8(qraw[ks], qf8);     \
        u32x4_t w; w.x = cvt2(qf8[0] * SC, qf8[1] * SC); w.y = cvt2(qf8[2] * SC, qf8[3] * SC); w.z = cvt2(qf8[4] * SC, qf8[5] * SC); w.w = cvt2(qf8[6] * SC, qf8[7] * SC); Qf[ks] = __builtin_bit_cast(bf16x8_t, w); }
    f32x4_t O[8];
#pragma unroll
    for (int dt = 0; dt < 8; ++dt) O[dt] = (f32x4_t){0.f, 0.f, 0.f, 0.f};
    float m; f32x4_t Lacc = (f32x4_t){0.f, 0.f, 0.f, 0.f};
    const bf16x8_t ones8_ = (bf16x8_t){0x3F80, 0x3F80, 0x3F80, 0x3F80, 0x3F80, 0x3F80, 0x3F80, 0x3F80};
    __syncthreads();
#define ATT_STAGE(jb, kslot, vslot) do { LAS unsigned char* kl_ = lds + (kslot) * 16384 + wave * 1024; LAS unsigned char* vl_ = lds + 49152 + (vslot) * 16384 + wave * 1024; \
        const char* kp_ = (const char*)K + (size_t)(jb) * 64 * ldk * 2; const char* vp_ = (const char*)VT + (size_t)(jb) * 128; \
        __builtin_amdgcn_global_load_lds((const unsigned*)(kp_ + voffK), (LAS unsigned*)kl_, 16, 0, 0); \
        __builtin_amdgcn_global_load_lds((const unsigned*)(kp_ + 128 + voffK), (LAS unsigned*)(kl_ + 8192), 16, 0, 0); \
        __builtin_amdgcn_global_load_lds((const unsigned*)(vp_ + voffV[0]), (LAS unsigned*)vl_, 16, 0, 0); \
        __builtin_amdgcn_global_load_lds((const unsigned*)(vp_ + voffV[1]), (LAS unsigned*)(vl_ + 8192), 16, 0, 0); } while (0)
    ATT_STAGE(0, 0, 0); ATT_STAGE(1, 1, 1); ATT_STAGE(2, 2, 2);
    __builtin_amdgcn_sched_barrier(0);
    ATT_QCONV();
#undef ATT_QCONV
    asm volatile("s_waitcnt vmcnt(8)" ::: "memory");
    __builtin_amdgcn_s_barrier();
    asm volatile("" ::: "memory");
    f32x4_t S[4], Sn[4];
    bf16x8_t Yp[2] = {(bf16x8_t){0, 0, 0, 0, 0, 0, 0, 0}, (bf16x8_t){0, 0, 0, 0, 0, 0, 0, 0}};
    { const LAS unsigned char* ks_ = lds + comp * 8192 + aoff;
#pragma unroll
      for (int kt = 0; kt < 4; ++kt) { S[kt] = (f32x4_t){0.f, 0.f, 0.f, 0.f};
#pragma unroll
          for (int ks = 0; ks < 2; ++ks) S[kt] = __builtin_amdgcn_mfma_f32_16x16x32_bf16(*(const LAS bf16x8_t*)(ks_ + kt * 2048 + ks * 1024), Qf[ks], S[kt], 0, 0, 0); }
      float mx0 = fmaxf(fmaxf(fmaxf(fmaxf(S[0].x, S[0].y), fmaxf(S[0].z, S[0].w)), fmaxf(fmaxf(S[1].x, S[1].y), fmaxf(S[1].z, S[1].w))), fmaxf(fmaxf(fmaxf(S[2].x, S[2].y), fmaxf(S[2].z, S[2].w)), fmaxf(fmaxf(S[3].x, S[3].y), fmaxf(S[3].z, S[3].w))));
      m = xrow_max(mx0);
#pragma unroll
      for (int kt = 0; kt < 4; ++kt) S[kt] = S[kt] - m; }
    int vm1 = 0  , vj = 0  , vp3 = 3  ;
    for (int j = 0; j < NJ; ++j) {
        if (j + 2 < NJ) asm volatile("s_waitcnt vmcnt(4)" ::: "memory"); else asm volatile("s_waitcnt vmcnt(0)" ::: "memory");
        __builtin_amdgcn_s_barrier();
        asm volatile("" ::: "memory");
        if (j + 3 < NJ) ATT_STAGE(j + 3, j % 3, vp3);
        __builtin_amdgcn_sched_barrier(0);
        bf16x8_t Yn[2]; float alpha = 1.0f, dfix = 0.f; bool anyfix = false;
        const f32x4_t negm4_ = (f32x4_t){-m, -m, -m, -m};
        const LAS unsigned char* ksl_ = lds + ((j + 1) % 3) * 16384 + comp * 8192 + aoff; const LAS unsigned char* vsl_ = lds + 49152 + vm1 * 16384 + aoff;
#define SB_ __builtin_amdgcn_sched_barrier(0)
        { float mx_; bf16x8_t fA_, fB_, fC_, fD_, fE_, fF_;
          fA_ = *(const LAS bf16x8_t*)(ksl_ + 0); fB_ = *(const LAS bf16x8_t*)(ksl_ + 2048); fC_ = *(const LAS bf16x8_t*)(ksl_ + 4096); fD_ = *(const LAS bf16x8_t*)(ksl_ + 6144); fE_ = *(const LAS bf16x8_t*)(ksl_ + 1024);
          fF_ = *(const LAS bf16x8_t*)(ksl_ + 3072); Sn[0] = __builtin_amdgcn_mfma_f32_16x16x32_bf16(fA_, Qf[0], negm4_, 0, 0, 0); SB_;
          fA_ = *(const LAS bf16x8_t*)(ksl_ + 5120); Sn[1] = __builtin_amdgcn_mfma_f32_16x16x32_bf16(fB_, Qf[0], negm4_, 0, 0, 0); mx_ = fmaxf(fmaxf(fmaxf(S[0].x, S[0].y), fmaxf(S[0].z, S[0].w)), fmaxf(fmaxf(S[1].x, S[1].y), fmaxf(S[1].z, S[1].w))); SB_;
          fB_ = *(const LAS bf16x8_t*)(ksl_ + 7168); Sn[2] = __builtin_amdgcn_mfma_f32_16x16x32_bf16(fC_, Qf[0], negm4_, 0, 0, 0); SB_;
          fC_ = *(const LAS bf16x8_t*)(vsl_ + 0); Sn[3] = __builtin_amdgcn_mfma_f32_16x16x32_bf16(fD_, Qf[0], negm4_, 0, 0, 0); mx_ = fmaxf(mx_, fmaxf(fmaxf(fmaxf(S[2].x, S[2].y), fmaxf(S[2].z, S[2].w)), fmaxf(fmaxf(S[3].x, S[3].y), fmaxf(S[3].z, S[3].w)))); SB_;
          fD_ = *(const LAS bf16x8_t*)(vsl_ + 2048); Sn[0] = __builtin_amdgcn_mfma_f32_16x16x32_bf16(fE_, Qf[1], Sn[0], 0, 0, 0); SB_;
          fE_ = *(const LAS bf16x8_t*)(vsl_ + 4096); Sn[1] = __builtin_amdgcn_mfma_f32_16x16x32_bf16(fF_, Qf[1], Sn[1], 0, 0, 0); mx_ = xrow_max(mx_); anyfix = __any(mx_ > FIXTHR); if (anyfix) { dfix = mx_ > FIXTHR ? mx_ : 0.f; m += dfix; alpha = __builtin_amdgcn_exp2f(-dfix); _Pragma("unroll") for (int kt = 0; kt < 4; ++kt) S[kt] = S[kt] - dfix; } SB_;
          fF_ = *(const LAS bf16x8_t*)(vsl_ + 6144); Sn[2] = __builtin_amdgcn_mfma_f32_16x16x32_bf16(fA_, Qf[1], Sn[2], 0, 0, 0); SB_;
          fA_ = *(const LAS bf16x8_t*)(vsl_ + 8192); Sn[3] = __builtin_amdgcn_mfma_f32_16x16x32_bf16(fB_, Qf[1], Sn[3], 0, 0, 0); SB_;
          fB_ = *(const LAS bf16x8_t*)(vsl_ + 10240); O[0] = __builtin_amdgcn_mfma_f32_16x16x32_bf16(fC_, Yp[0], O[0], 0, 0, 0); S[0].x = __builtin_amdgcn_exp2f(S[0].x); S[0].y = __builtin_amdgcn_exp2f(S[0].y); S[0].z = __builtin_amdgcn_exp2f(S[0].z); S[0].w = __builtin_amdgcn_exp2f(S[0].w); SB_;
          fC_ = *(const LAS bf16x8_t*)(vsl_ + 12288); O[1] = __builtin_amdgcn_mfma_f32_16x16x32_bf16(fD_, Yp[0], O[1], 0, 0, 0); SB_;
          fD_ = *(const LAS bf16x8_t*)(vsl_ + 14336); O[2] = __builtin_amdgcn_mfma_f32_16x16x32_bf16(fE_, Yp[0], O[2], 0, 0, 0); SB_;
          fE_ = *(const LAS bf16x8_t*)(vsl_ + 1024); O[3] = __builtin_amdgcn_mfma_f32_16x16x32_bf16(fF_, Yp[0], O[3], 0, 0, 0); S[1].x = __builtin_amdgcn_exp2f(S[1].x); S[1].y = __builtin_amdgcn_exp2f(S[1].y); S[1].z = __builtin_amdgcn_exp2f(S[1].z); S[1].w = __builtin_amdgcn_exp2f(S[1].w); SB_;
          fF_ = *(const LAS bf16x8_t*)(vsl_ + 3072); O[4] = __builtin_amdgcn_mfma_f32_16x16x32_bf16(fA_, Yp[0], O[4], 0, 0, 0); SB_;
          fA_ = *(const LAS bf16x8_t*)(vsl_ + 5120); O[5] = __builtin_amdgcn_mfma_f32_16x16x32_bf16(fB_, Yp[0], O[5], 0, 0, 0); SB_;
          fB_ = *(const LAS bf16x8_t*)(vsl_ + 7168); O[6] = __builtin_amdgcn_mfma_f32_16x16x32_bf16(fC_, Yp[0], O[6], 0, 0, 0); S[2].x = __builtin_amdgcn_exp2f(S[2].x); S[2].y = __builtin_amdgcn_exp2f(S[2].y); S[2].z = __builtin_amdgcn_exp2f(S[2].z); S[2].w = __builtin_amdgcn_exp2f(S[2].w); SB_;
          fC_ = *(const LAS bf16x8_t*)(vsl_ + 9216); O[7] = __builtin_amdgcn_mfma_f32_16x16x32_bf16(fD_, Yp[0], O[7], 0, 0, 0); SB_;
          Lacc = __builtin_amdgcn_mfma_f32_16x16x32_bf16(ones8_, Yp[0], Lacc, 0, 0, 0); SB_;
          fD_ = *(const LAS bf16x8_t*)(vsl_ + 11264); O[0] = __builtin_amdgcn_mfma_f32_16x16x32_bf16(fE_, Yp[1], O[0], 0, 0, 0); S[3].x = __builtin_amdgcn_exp2f(S[3].x); S[3].y = __builtin_amdgcn_exp2f(S[3].y); S[3].z = __builtin_amdgcn_exp2f(S[3].z); S[3].w = __builtin_amdgcn_exp2f(S[3].w); SB_;
          fE_ = *(const LAS bf16x8_t*)(vsl_ + 13312); O[1] = __builtin_amdgcn_mfma_f32_16x16x32_bf16(fF_, Yp[1], O[1], 0, 0, 0); SB_;
          fF_ = *(const LAS bf16x8_t*)(vsl_ + 15360); O[2] = __builtin_amdgcn_mfma_f32_16x16x32_bf16(fA_, Yp[1], O[2], 0, 0, 0); SB_;
          O[3] = __builtin_amdgcn_mfma_f32_16x16x32_bf16(fB_, Yp[1], O[3], 0, 0, 0); Yn[0] = pack8(S[0], S[1]); Yn[1] = pack8(S[2], S[3]); SB_;
          O[4] = __builtin_amdgcn_mfma_f32_16x16x32_bf16(fC_, Yp[1], O[4], 0, 0, 0); SB_;
          O[5] = __builtin_amdgcn_mfma_f32_16x16x32_bf16(fD_, Yp[1], O[5], 0, 0, 0); SB_;
          O[6] = __builtin_amdgcn_mfma_f32_16x16x32_bf16(fE_, Yp[1], O[6], 0, 0, 0); SB_;
          O[7] = __builtin_amdgcn_mfma_f32_16x16x32_bf16(fF_, Yp[1], O[7], 0, 0, 0); SB_;
          Lacc = __builtin_amdgcn_mfma_f32_16x16x32_bf16(ones8_, Yp[1], Lacc, 0, 0, 0); SB_;
        }
        asm volatile("" : "+v"(Yn[0]), "+v"(Yn[1]));
#undef SB_
        __builtin_amdgcn_sched_barrier(0);
        if (anyfix) {
#pragma unroll
            for (int dt = 0; dt < 8; ++dt) O[dt] = O[dt] * alpha;
            Lacc = Lacc * alpha;
#pragma unroll
            for (int kt = 0; kt < 4; ++kt) Sn[kt] = Sn[kt] - dfix; }
#pragma unroll
        for (int kt = 0; kt < 4; ++kt) S[kt] = Sn[kt];
        Yp[0] = Yn[0]; Yp[1] = Yn[1];
        vm1 = vj; vj = vj == 4 ? 0 : vj + 1; vp3 = vp3 == 4 ? 0 : vp3 + 1;
    }
    { const LAS unsigned char* vs_ = lds + 49152 + vm1 * 16384 + aoff;
#pragma unroll
      for (int jj = 0; jj < 2; ++jj)
#pragma unroll
          for (int dt = 0; dt < 8; ++dt) O[dt] = __builtin_amdgcn_mfma_f32_16x16x32_bf16(*(const LAS bf16x8_t*)(vs_ + dt * 2048 + jj * 1024), Yp[jj], O[dt], 0, 0, 0);
      Lacc = __builtin_amdgcn_mfma_f32_16x16x32_bf16(ones8_, Yp[0], Lacc, 0, 0, 0); Lacc = __builtin_amdgcn_mfma_f32_16x16x32_bf16(ones8_, Yp[1], Lacc, 0, 0, 0); }
#undef ATT_STAGE
    if (part) {
        float* po = part + (size_t)(comp * 64 + 16 * wq + fr) * 128 + 4 * fq;
#pragma unroll
        for (int dt = 0; dt < 8; ++dt) *(f32x4_t*)(po + 16 * dt) = O[dt];
        if (fq == 0) { part[16384 + comp * 64 + 16 * wq + fr] = m; part[16384 + 128 + comp * 64 + 16 * wq + fr] = Lacc.x; }
        return;
    }
    const float lam = lamp[0], lam_init = lamp[1];
    { const float f = (comp ? lam : 1.0f) / Lacc.x;
#pragma unroll
      for (int dt = 0; dt < 8; ++dt) O[dt] = O[dt] * f; }
    __syncthreads();
    LAS float* ex = (LAS float*)lds;
    if (comp == 1) {
#pragma unroll
        for (int dt = 0; dt < 8; ++dt) *(LAS f32x4_t*)(ex + (16 * wq + fr) * 132 + 16 * dt + 4 * fq) = O[dt]; }
    __syncthreads();
    if (comp == 0) { float ss = 0.f;
#pragma unroll
        for (int dt = 0; dt < 8; ++dt) { O[dt] = O[dt] - *(const LAS f32x4_t*)(ex + (16 * wq + fr) * 132 + 16 * dt + 4 * fq);
            ss += (O[dt].x * O[dt].x + O[dt].y * O[dt].y) + (O[dt].z * O[dt].z + O[dt].w * O[dt].w); }
        ss += lane_get(ss, lane ^ 16); ss += lane_get(ss, lane ^ 32);
        const float r = rsqrtf(ss * (1.0f / 128.0f) + EPS) * (1.0f - lam_init);
        bf16_t* orow = CATrow0 + (size_t)(16 * wq + fr) * D;
#pragma unroll
        for (int dt = 0; dt < 8; ++dt) { const f32x4_t g = *(const f32x4_t*)(dnorm + 16 * dt + 4 * fq); const f32x4_t y = O[dt] * r * g;
            *(unsigned long long*)(orow + 16 * dt + 4 * fq) = (unsigned long long)pk2(y.x, y.y) | ((unsigned long long)pk2(y.z, y.w) << 32); }
    }
}
constexpr int PART_STRIDE = 16384 + 256;
__device__ __forceinline__ void attn_merge_row(int row, const float* __restrict__ part, const float* __restrict__ lamp, const float* __restrict__ dnorm, bf16_t* __restrict__ CAT, int lane) {
    const int u = row >> 6, r = row & 63; const float* pa = part + (size_t)(2 * u) * PART_STRIDE; const float* pb = pa + PART_STRIDE;
    float o[2][2];
#pragma unroll
    for (int c = 0; c < 2; ++c) { const float ma = pa[16384 + c * 64 + r], mb = pb[16384 + c * 64 + r], la = pa[16384 + 128 + c * 64 + r], lb = pb[16384 + 128 + c * 64 + r];
        const float mm = fmaxf(ma, mb), wa = __builtin_amdgcn_exp2f(ma - mm), wb = __builtin_amdgcn_exp2f(mb - mm), inv = 1.0f / (la * wa + lb * wb);
#pragma unroll
        for (int q = 0; q < 2; ++q) o[c][q] = (pa[(size_t)(c * 64 + r) * 128 + lane + 64 * q] * wa + pb[(size_t)(c * 64 + r) * 128 + lane + 64 * q] * wb) * inv; }
    const float lam = lamp[0], lam_init = lamp[1];
    const float x0 = o[0][0] - lam * o[1][0], x1 = o[0][1] - lam * o[1][1];
    const float rr = rsqrtf(wave_sum(x0 * x0 + x1 * x1, lane) * (1.0f / 128.0f) + EPS) * (1.0f - lam_init);
    bf16_t* orow = CAT + (size_t)(MCTX + 4096 + row) * D + 512 + 7 * 128;
    orow[lane] = (bf16_t)f2bf(x0 * rr * dnorm[lane]); orow[64 + lane] = (bf16_t)f2bf(x1 * rr * dnorm[64 + lane]);
}
__device__ __forceinline__ void vt_item_bf16(const bf16_t* __restrict__ Vsrc, int ldsrc, bf16_t* __restrict__ VTdst, int ldv, int lane) {
    u32x4_t v[16];
#pragma unroll
    for (int i = 0; i < 16; ++i) v[i] = *(const u32x4_t*)(Vsrc + (size_t)lane * ldsrc + 8 * i);
    const int pos = posinv(lane);
#pragma unroll
    for (int i = 0; i < 16; ++i) { const unsigned w[4] = {v[i].x, v[i].y, v[i].z, v[i].w};
#pragma unroll
        for (int j = 0; j < 4; ++j) { VTdst[(size_t)(8 * i + 2 * j) * ldv + pos] = (bf16_t)(w[j] & 0xffffu); VTdst[(size_t)(8 * i + 2 * j + 1) * ldv + pos] = (bf16_t)(w[j] >> 16); } }
}
__device__ __forceinline__ void vt_item_f32(const float* __restrict__ Vsrc, int ldsrc, bf16_t* __restrict__ VTdst, int ldv, int lane) {
    const int pos = posinv(lane);
#pragma unroll
    for (int hb = 0; hb < 2; ++hb) { f32x4_t v[16];
#pragma unroll
        for (int i = 0; i < 16; ++i) v[i] = *(const f32x4_t*)(Vsrc + (size_t)lane * ldsrc + 4 * (16 * hb + i));
#pragma unroll
        for (int i = 0; i < 16; ++i) { const int c = 4 * (16 * hb + i);
            VTdst[(size_t)c * ldv + pos] = (bf16_t)f2bf(v[i].x); VTdst[(size_t)(c + 1) * ldv + pos] = (bf16_t)f2bf(v[i].y); VTdst[(size_t)(c + 2) * ldv + pos] = (bf16_t)f2bf(v[i].z); VTdst[(size_t)(c + 3) * ldv + pos] = (bf16_t)f2bf(v[i].w); } }
}
typedef const __attribute__((address_space(4))) Args* KArgs;
__device__ __forceinline__ KArgs fresh_args() { KArgs k = (KArgs)__builtin_amdgcn_kernarg_segment_ptr(); asm volatile("" : "+s"(k)); return k; }
__device__ __forceinline__ void tail_convert(KArgs ka, LAS unsigned char* lds, int lo, int hi, int idx, int stride, int wave, int lane) {
    LAS float* scr = (LAS float*)(lds + wave * 8448); unsigned char* const W1 = ka->ws + WS_W + W_LAYER;
    for (int d = lo + idx; d < hi; d += stride) {
        const float* src; int ld, Kdst, mode, nblk, r; size_t wofs;
        if (d < DM1) { r = d; src = ka->in[10] + (size_t)D * NFF; ld = NFF; wofs = W_1IN; Kdst = D; mode = 1; nblk = NFF / 32; }
        else if (d < DM2) { r = d - DM1; src = ka->in[11] + (size_t)DFF * D; ld = D; wofs = W_1OUT; Kdst = DFF; mode = 0; nblk = D / 32; }
        else if (d < DM3) { r = d - DM2; src = ka->in[13] + (size_t)D * IN_COLS; ld = IN_COLS; wofs = W_IN; Kdst = D; mode = 2; nblk = NPROJ / 32; }
        else if (d < DM4) { r = d - DM3; src = ka->in[24] + (size_t)D * NFF; ld = NFF; wofs = W_2IN; Kdst = D; mode = 1; nblk = NFF / 32; }
        else if (d < DM5) { r = d - DM4; src = ka->in[22] + (size_t)D * D; ld = D; wofs = W_OUT; Kdst = D; mode = 0; nblk = D / 32; }
        else { r = d - DM5; src = ka->in[25] + (size_t)DFF * D; ld = D; wofs = W_2OUT; Kdst = DFF; mode = 0; nblk = D / 32; }
        tr_item(src, ld, (bf16_t*)(W1 + wofs), Kdst, mode, r, nblk, scr, lane, nullptr, nullptr); }
}
#define PHASE_IDS FRESH_LDS; const int tid = fresh_tid_w(wave_s), lane = tid & 63, wave = __builtin_amdgcn_readfirstlane(tid >> 6), gw = wg * NWAVES + wave; (void)lane; (void)gw; (void)lds
#define PHASE_PTRS KArgs ka = fresh_args(); unsigned char* const ws = ka->ws; float* const out = ka->out; (void)out; \
    float* const ADA = (float*)(ws + WS_ADA); float* const LAM = (float*)(ws + WS_LAM); float* const X = (float*)(ws + WS_X); bf16_t* const H = (bf16_t*)(ws + WS_H); bf16_t* const CAT = (bf16_t*)(ws + WS_CAT); \
    bf16_t* const ACT = (bf16_t*)(ws + WS_ACT); bf16_t* const P = (bf16_t*)(ws + WS_PROJ); float* const AB = (float*)(ws + WS_AB); float* const GQ = (float*)(ws + WS_GQ); float* const GK = (float*)(ws + WS_GK); \
    float* const GV = (float*)(ws + WS_GV); float* const GG = (float*)(ws + WS_GG); float* const GB = (float*)(ws + WS_GB); float* const OF = (float*)(ws + WS_OF); float* const OB = (float*)(ws + WS_OB); \
    bf16_t* const QB = (bf16_t*)(ws + WS_QB); bf16_t* const KB = (bf16_t*)(ws + WS_KB); bf16_t* const VTL = (bf16_t*)(ws + WS_VTL); bf16_t* const VTC = (bf16_t*)(ws + WS_VTC); \
    const unsigned char* const Wl = ws + WS_W + (size_t)l * W_LAYER; const float* const ada = ADA + (size_t)l * 3 * ADA_N; \
    (void)LAM; (void)X; (void)H; (void)CAT; (void)ACT; (void)P; (void)AB; (void)GQ; (void)GK; (void)GV; (void)GG; (void)GB; (void)OF; (void)OB; (void)QB; (void)KB; (void)VTL; (void)VTC; (void)Wl; (void)ada
__global__ void __launch_bounds__(NWAVES * 64, 2) mega_fwd(Args a) {
    extern __shared__ __attribute__((aligned(16))) unsigned char lds_raw[];
    LAS unsigned char* const lds0 = (LAS unsigned char*)lds_raw;
#define FRESH_LDS LAS unsigned char* lds = lds0; asm volatile("" : "+s"(lds))
    const int G = gridDim.x, wg = blockIdx.x, NGW = G * NWAVES, wave_s = __builtin_amdgcn_readfirstlane(threadIdx.x >> 6);
    if (threadIdx.x < 64) ((LAS unsigned*)(lds0 + LDS_MISC))[threadIdx.x] = 0u;
    __syncthreads();
    (void)xcd_barrier_post((unsigned*)(a.ws + WS_CTL) + CW_BAR, (volatile LAS unsigned*)(lds0 + LDS_MISC + 32));
#define GRID_BARRIER() do { FRESH_LDS; KArgs kb_ = fresh_args(); XcdBarrier b_; b_.bar = (unsigned*)(kb_->ws + WS_CTL) + CW_BAR; b_.x = xb_xcc_id(); b_.st = (volatile LAS unsigned*)(lds + LDS_MISC + 32); xcd_barrier(b_, fresh_tid_w(wave_s)); } while (0)

    { PHASE_IDS; KArgs ka = fresh_args(); Ptrs p;
      p.x_prompt = ka->in[0]; p.x_sample = ka->in[1]; p.c = ka->in[2]; p.cache_k = ka->in[3]; p.cache_v = ka->in[4]; p.state_gdn = ka->in[5]; p.c_ctx = ka->in[6]; p.w_ada = ka->in[7]; p.b_ada = ka->in[8];
      p.norm_ffn1 = ka->in[9]; p.ffn1_in = ka->in[10]; p.ffn1_out = ka->in[11]; p.norm_mix = ka->in[12]; p.w_in = ka->in[13]; p.gdn_conv = ka->in[14]; p.gdn_a_log = ka->in[15]; p.gdn_dt_bias = ka->in[16];
      p.gdn_norm = ka->in[17]; p.diff_lam = ka->in[18]; p.diff_norm = ka->in[19]; p.pool_w = ka->in[20]; p.pool_scale = ka->in[21]; p.w_out = ka->in[22]; p.norm_ffn2 = ka->in[23]; p.ffn2_in = ka->in[24];
      p.ffn2_out = ka->in[25]; p.final_norm = ka->in[26];
      ph_prologue(p, ka->ws, lds, gw, NGW, wave, lane, tid); }
    GRID_BARRIER();

    for (int l = 0; l < DEPTH; ++l) {
        { PHASE_IDS; PHASE_PTRS; const float* x_prompt = ka->in[0]; const float* x_sample = ka->in[1]; const float* gain = ka->in[9] + l * D;
          for (int row = gw; row < M; row += NGW) {
            const float* xrow = (l == 0) ? (row < MCTX ? x_prompt + (size_t)row * D : x_sample + (size_t)(row - MCTX) * D) : X + (size_t)row * D;
            norm_row(xrow, row, gain, ada + 0 * D, ada + 1 * D, H, nullptr, lane);
        } }
        GRID_BARRIER();
        { FRESH_LDS; PHASE_PTRS; pg8::Gemm g{H, (const bf16_t*)(Wl + W_1IN), M, NFF, D, 0}; pg8::StaticOrder S; S.init(M, NFF, G, wg); pg8::EpiSwiglu E{ACT, DFF, 0};
          pg8::gemm_phase<pg8::EpiSwiglu, pg8::StaticOrder, true, true>(lds, g, S, E, fresh_tid_w(wave_s)); }
        if (G == 256 && wg >= 128) { __syncthreads(); PHASE_IDS; KArgs ka = fresh_args(); tail_convert(ka, lds, l ? DSEG3 : DSEG0, l ? DSEG4 : DSEG1, (wg - 128) * NWAVES + wave, 128 * NWAVES, wave, lane); }
        GRID_BARRIER();
        { FRESH_LDS; PHASE_PTRS; pg8::Gemm g{ACT, (const bf16_t*)(Wl + W_1OUT), M, D, DFF, 0}; pg8::StaticOrder S; S.init(M, D, G, wg, 192); const float* r0_ = l == 0 ? ka->in[0] : X; const float* r1_ = l == 0 ? ka->in[1] : X + (size_t)4096 * D; pg8::EpiResidTQ E{X, r0_, r1_, ada + 2 * D, D, ADA_N, 0.5f, 0};
          pg8::gemm_phase<pg8::EpiResidTQ, pg8::StaticOrder, true, true, true>(lds, g, S, E, fresh_tid_w(wave_s)); }
        GRID_BARRIER();
        { PHASE_IDS; PHASE_PTRS; const float* gain = ka->in[12] + l * D;
          for (int row = gw; row < M; row += NGW) norm_row(X + (size_t)row * D, row, gain, ada + 3 * D, ada + 4 * D, H, nullptr, lane); }
        GRID_BARRIER();
        { FRESH_LDS; PHASE_PTRS; pg8::Gemm g{H, (const bf16_t*)(Wl + W_IN), M, NPROJ, D, 0}; pg8::StaticOrder S; S.init(M, NPROJ, G, wg);
          pg8::EpiProj E{P, AB};
          pg8::gemm_phase<pg8::EpiProj, pg8::StaticOrder, true, true>(lds, g, S, E, fresh_tid_w(wave_s)); }
        if (G == 256 && wg >= 160) { __syncthreads(); PHASE_IDS; KArgs ka = fresh_args(); tail_convert(ka, lds, l ? DSEG4 : DSEG1, l ? DSEG5 : DSEG2, (wg - 160) * NWAVES + wave, 96 * NWAVES, wave, lane); }
        GRID_BARRIER();
        { PHASE_IDS; PHASE_PTRS; const float* cache_k = ka->in[3]; const float* cache_v = ka->in[4]; const float* conv = ka->in[14] + (size_t)l * 4 * 1536; const float* a_log = ka->in[15] + l * 8; const float* dt_bias = ka->in[16] + l * 8;
          for (int item = wg; item < 768; item += G) gdn_prep_item(item, P, AB, conv, a_log, dt_bias, ws + WS_GBLK, lds, tid);
          __syncthreads();
          LAS float* tab = (LAS float*)lds;
          for (int i = tid; i < 1024; i += NWAVES * 64) { float sn, cs; sincosf((float)(i >> 4) * __expf(-(float)(i & 15) * 0.5756462732485114f), &sn, &cs); tab[2 * i] = cs; tab[2 * i + 1] = sn; }
          __syncthreads();
          for (int row = gw; row < M + 2 * PAST + 1664; row += NGW) {
            if (row < M) {
                u32x4_t xr[4];
                if (row >= MCTX) rope_load(row - MCTX, P, lane, xr);
                else {
#pragma unroll
                    for (int i = 0; i < 2; ++i) { xr[2 * i] = *(const u32x4_t*)(P + (size_t)row * PROJW + 3072 + 8 * (lane + 64 * i)); xr[2 * i + 1] = *(const u32x4_t*)(P + (size_t)row * PROJW + 4096 + 8 * (lane + 64 * i)); } }
                pool_row(row, P, CAT, lane);
                if (row >= MCTX) rope_finish(row - MCTX, xr, QB, KB, tab, lane);
                else { float* ck = out + OUT_CK + (((size_t)(row >> 8) * 2 + l) * 256 + (row & 255)) * 1024; float* cv = out + OUT_CV + (((size_t)(row >> 8) * 2 + l) * 256 + (row & 255)) * 1024;
#pragma unroll
                    for (int i = 0; i < 2; ++i) { float fk[8], fv[8]; unpack8(xr[2 * i], fk); unpack8(xr[2 * i + 1], fv);
                        *(f32x4_t*)(ck + 8 * (lane + 64 * i)) = (f32x4_t){fk[0], fk[1], fk[2], fk[3]}; *(f32x4_t*)(ck + 8 * (lane + 64 * i) + 4) = (f32x4_t){fk[4], fk[5], fk[6], fk[7]};
                        *(f32x4_t*)(cv + 8 * (lane + 64 * i)) = (f32x4_t){fv[0], fv[1], fv[2], fv[3]}; *(f32x4_t*)(cv + 8 * (lane + 64 * i) + 4) = (f32x4_t){fv[4], fv[5], fv[6], fv[7]}; } }
            } else if (row < M + 2 * PAST) {
                const int r = row - M, b = r >> 9, kk = r & 511; const size_t sidx = (((size_t)b * DEPTH + l) * PAST + kk) * 1024, d = ((size_t)b * LK_LAT + kk) * 1024;
#pragma unroll
                for (int i = 0; i < 2; ++i) { const f32x4_t v0 = *(const f32x4_t*)(cache_k + sidx + 8 * (lane + 64 * i)), v1 = *(const f32x4_t*)(cache_k + sidx + 8 * (lane + 64 * i) + 4);
                    u32x4_t w; w.x = pk2(v0.x, v0.y); w.y = pk2(v0.z, v0.w); w.z = pk2(v1.x, v1.y); w.w = pk2(v1.z, v1.w); *(u32x4_t*)(KB + d + 8 * (lane + 64 * i)) = w; }
            } else {
                const int it = row - (M + 2 * PAST);
                if (it < 1152) { const int b = it / 576, r2 = it - b * 576, h = r2 / 72, kblk = r2 - h * 72; bf16_t* dst = VTL + ((size_t)(b * 8 + h) * 128) * LK_LAT + 64 * kblk;
                    if (kblk < 8) vt_item_f32(cache_v + (((size_t)b * DEPTH + l) * PAST + 64 * kblk) * 1024 + h * 128, 1024, dst, LK_LAT, lane);
                    else vt_item_bf16(P + (size_t)(MCTX + b * 4096 + 64 * (kblk - 8)) * PROJW + 4096 + h * 128, PROJW, dst, LK_LAT, lane); }
                else { const int i2 = it - 1152, b = i2 >> 5, h = (i2 >> 2) & 7, kblk = i2 & 3;
                    vt_item_bf16(P + (size_t)(b * 256 + 64 * kblk) * PROJW + 4096 + h * 128, PROJW, VTC + ((size_t)(b * 8 + h) * 128) * 256 + 64 * kblk, 256, lane); }
            }
          } }
        GRID_BARRIER();
        { PHASE_IDS; PHASE_PTRS; const float* state_gdn = ka->in[5];
          for (int ci = wg; ci < 144; ci += G) gdn_scan_chain(ci < 16 ? 128 + ci : ci - 16, ws + WS_GBLK, OF, OB, state_gdn, out + OUT_ST, l, lds, tid); }
        { PHASE_IDS; PHASE_PTRS; const float* dnorm = ka->in[19] + l * 128; unsigned* qhead = (unsigned*)(ws + WS_CTL) + CW_QUEUE + 64 * l; LAS unsigned* qslot = (LAS unsigned*)(lds + LDS_MISC + 64);
          bool lat_open = wg >= 16 || G < 32;
          for (;;) {
            __syncthreads();
            if (tid == 0) { unsigned it = 0xffffffffu; if (lat_open) { it = atomicAdd(qhead, 1u); if (it >= 1088u) it = 0xffffffffu; } if (it == 0xffffffffu) { it = atomicAdd(qhead + 128, 1u); it = it < 512u ? it + 1088u : 0xffffffffu; } *qslot = it; }
            __syncthreads();
            const unsigned item = *qslot;
            if (item >= 1600u) break;
            if (item >= 1088u) lat_open = false;
            const bf16_t *aQ, *aK, *aV; int ldq, ldk, ldv, nb, qrow0, hh; float* part = nullptr;
            if (item < 1088u) { const unsigned fu = item < 960u ? item : 960u + ((item - 960u) >> 1); const int kh = item < 960u ? -1 : (int)((item - 960u) & 1u);
                const int b = fu >> 9, h = (fu >> 6) & 7, qb = fu & 63; qrow0 = MCTX + b * 4096 + 64 * qb; hh = h;
                aQ = QB + (size_t)(b * 4096 + 64 * qb) * 1024 + h * 128; ldq = 1024; aK = KB + (size_t)b * LK_LAT * 1024 + h * 128; ldk = 1024; aV = VTL + ((size_t)(b * 8 + h) * 128) * LK_LAT; ldv = LK_LAT; nb = LK_LAT / 64;
                if (kh >= 0) { nb = LK_LAT / 128; aK += (size_t)kh * (LK_LAT / 2) * 1024; aV += (size_t)kh * (LK_LAT / 2); part = (float*)(ws + WS_ACT) + (size_t)((fu - 960u) * 2u + (unsigned)kh) * PART_STRIDE; } }
            else { const int i2 = item - 1088, b = i2 >> 5, h = (i2 >> 2) & 7, qb = i2 & 3; qrow0 = b * 256 + 64 * qb; hh = h;
                aQ = P + (size_t)qrow0 * PROJW + 2048 + h * 128; ldq = PROJW; aK = P + (size_t)(b * 256) * PROJW + 3072 + h * 128; ldk = PROJW; aV = VTC + ((size_t)(b * 8 + h) * 128) * 256; ldv = 256; nb = 4; }
            attn_unit(aQ, ldq, aK, ldk, aV, ldv, nb, LAM + 2 * l, dnorm, CAT + (size_t)qrow0 * D + 512 + hh * 128, lds, tid, part);
        } }
        GRID_BARRIER();
        { PHASE_IDS; PHASE_PTRS; const float* gnorm = ka->in[17] + l * 128;
          for (int row = gw; row < M; row += NGW) gdn_out_row(row, OF, OB, P, gnorm, CAT, lane);
          for (int row = gw; row < 4096; row += NGW) attn_merge_row(row, (const float*)(ws + WS_ACT), LAM + 2 * l, ka->in[19] + l * 128, CAT, lane); }
        GRID_BARRIER();
        { FRESH_LDS; PHASE_PTRS; pg8::Gemm g{CAT, (const bf16_t*)(Wl + W_OUT), M, D, D, 0}; pg8::StaticOrder S; S.init(M, D, G, wg, 192); pg8::EpiResidTQ E{X, X, X + (size_t)4096 * D, ada + 5 * D, D, ADA_N, 1.0f, 0};
          pg8::gemm_phase<pg8::EpiResidTQ, pg8::StaticOrder, true, true, true>(lds, g, S, E, fresh_tid_w(wave_s)); }
        GRID_BARRIER();
        { PHASE_IDS; PHASE_PTRS; const float* gain = ka->in[23] + l * D;
          for (int row = gw; row < M; row += NGW) norm_row(X + (size_t)row * D, row, gain, ada + 6 * D, ada + 7 * D, H, nullptr, lane); }
        GRID_BARRIER();
        { FRESH_LDS; PHASE_PTRS; pg8::Gemm g{H, (const bf16_t*)(Wl + W_2IN), M, NFF, D, 0}; pg8::StaticOrder S; S.init(M, NFF, G, wg); pg8::EpiSwiglu E{ACT, DFF, 0};
          pg8::gemm_phase<pg8::EpiSwiglu, pg8::StaticOrder, true, true>(lds, g, S, E, fresh_tid_w(wave_s)); }
        if (G == 256 && wg >= 128) { __syncthreads(); PHASE_IDS; KArgs ka = fresh_args(); tail_convert(ka, lds, l ? DSEG5 : DSEG2, l ? DSEG6 : DSEG3, (wg - 128) * NWAVES + wave, 128 * NWAVES, wave, lane); }
        GRID_BARRIER();
        { FRESH_LDS; PHASE_PTRS; pg8::Gemm g{ACT, (const bf16_t*)(Wl + W_2OUT), M, D, DFF, 0}; pg8::StaticOrder S; S.init(M, D, G, wg, 192); pg8::EpiResidTQ E{X, X, X + (size_t)4096 * D, ada + 8 * D, D, ADA_N, 0.5f, 0};
          pg8::gemm_phase<pg8::EpiResidTQ, pg8::StaticOrder, true, true, true>(lds, g, S, E, fresh_tid_w(wave_s)); }
        GRID_BARRIER();
    }
    { const int l = 0; PHASE_IDS; PHASE_PTRS; const float* gain = ka->in[26];
      for (int row = gw; row < M; row += NGW) final_norm_row(X, row, gain, out, lane); }
}

extern "C" void kernel_launch(void* const* d_in, const int* in_sizes, int n_in, void* d_out, int out_size, void* d_ws, size_t ws_size, hipStream_t stream) {
    static int grid = 0;
    if (grid == 0) {
        if (n_in != 27 || out_size != (int)OUT_TOTAL || ws_size < WS_END) { fprintf(stderr, "kernel_launch: unexpected sizes n_in %d out %d ws %zu\n", n_in, out_size, ws_size); grid = -1; return; }
        int dev = 0, cus = 0, per_cu = 0; (void)hipGetDevice(&dev); (void)hipDeviceGetAttribute(&cus, hipDeviceAttributeMultiprocessorCount, dev);
        if (hipFuncSetAttribute((const void*)mega_fwd, hipFuncAttributeMaxDynamicSharedMemorySize, LDS_BYTES) != hipSuccess) { fprintf(stderr, "kernel_launch: hipFuncSetAttribute failed\n"); grid = -1; return; }
        if (hipOccupancyMaxActiveBlocksPerMultiprocessor(&per_cu, (const void*)mega_fwd, NWAVES * 64, LDS_BYTES) != hipSuccess || per_cu < 1) fprintf(stderr, "kernel_launch: occupancy query says %d\n", per_cu);
        (void)hipGetLastError();
        grid = cus > 0 ? cus : 256;
    }
    if (grid < 0) return;
    (void)hipMemsetAsync((char*)d_ws + WS_CTL, 0, CTL_BYTES + ADA_BYTES, stream);
    Args a{};
    for (int i = 0; i < 27; ++i) a.in[i] = (const float*)d_in[i];
    a.out = (float*)d_out; a.ws = (unsigned char*)d_ws;
    hipLaunchKernelGGL(mega_fwd, dim3(grid), dim3(NWAVES * 64), LDS_BYTES, stream, a);
}
```
